# Optimizing an MI355X kernel written in HIP

```python
import jax, jax.numpy as jnp
from jax import lax
import numpy as np

D_MODEL = 1024
BATCH = 2
SEQ = 16384
DEPTH = 2

N_A_LAYERS = DEPTH // 2
N_B_LAYERS = DEPTH - N_A_LAYERS
N_DENSE = (DEPTH + 1) // 2
N_MOE = DEPTH // 2
POOL_WINDOWS = (2, 4, 8, 16)
N_POOL_GROUPS = 4
POOL_GROUP_DIM = D_MODEL // N_POOL_GROUPS
HEAD_DIM = 128
N_HEADS = D_MODEL // HEAD_DIM
MOBA_BLOCK = 256
MOBA_TOPK = 3
Q_CHUNK = 128
ROPE_THETA = 500000.0
ROPE_DIM = HEAD_DIM // 4
D_FF = 2816
N_EXPERTS = 8
TOP_K_EXPERTS = 2
EXPERT_FF = 3584
PLE_DIM = 256
RMS_EPS = 1e-6
NEG_INF = -1e30

kernel_name = "yoco_pool_moba_moe_trunk"


def rms_norm(x, g):
    xf = x.astype(jnp.float32)
    var = jnp.mean(xf * xf, axis=-1, keepdims=True)
    return (xf * lax.rsqrt(var + RMS_EPS) * g.astype(jnp.float32)).astype(x.dtype)


def partial_rope(x, pos):
    half = ROPE_DIM // 2
    inv_freq = jnp.float32(ROPE_THETA) ** (-(jnp.arange(0, ROPE_DIM, 2, dtype=jnp.float32) / ROPE_DIM))
    ang = pos.astype(jnp.float32)[:, None] * inv_freq[None, :]
    cos, sin = jnp.cos(ang), jnp.sin(ang)
    xf = x.astype(jnp.float32)
    x1, x2, rest = xf[..., :half], xf[..., half:ROPE_DIM], xf[..., ROPE_DIM:]
    out = jnp.concatenate([x1 * cos - x2 * sin, x2 * cos + x1 * sin, rest], axis=-1)
    return out.astype(x.dtype)


def pool_mixer(xn, pool_w, pool_scale):
    B, S, D = xn.shape
    xf = xn.astype(jnp.float32)
    cs = jnp.cumsum(xf, axis=1)
    t = jnp.arange(S)
    outs = []
    for g, w in enumerate(POOL_WINDOWS):
        cg = cs[..., g * POOL_GROUP_DIM:(g + 1) * POOL_GROUP_DIM]
        shifted = jnp.concatenate(
            [jnp.zeros((B, w, POOL_GROUP_DIM), jnp.float32), cg[:, :S - w]], axis=1)
        cnt = jnp.minimum(t + 1, w).astype(jnp.float32)[None, :, None]
        outs.append((cg - shifted) / cnt)
    pooled = jnp.concatenate(outs, axis=-1) - xf
    pooled = pooled.reshape(B, S, N_POOL_GROUPS, POOL_GROUP_DIM).astype(xn.dtype)
    mixed = jnp.einsum('bsgc,gcd->bsgd', pooled, pool_w).reshape(B, S, D)
    return mixed * pool_scale


def shared_kv(h, kv_norm, w_k, w_v):
    B, S, D = h.shape
    kn = rms_norm(h, kv_norm)
    pos = jnp.arange(S)
    k = (kn @ w_k).reshape(B, S, N_HEADS, HEAD_DIM).transpose(0, 2, 1, 3)
    v = (kn @ w_v).reshape(B, S, N_HEADS, HEAD_DIM).transpose(0, 2, 1, 3)
    k = partial_rope(k, pos)
    nb = -(-S // MOBA_BLOCK)
    pad = nb * MOBA_BLOCK - S
    k = jnp.pad(k, ((0, 0), (0, 0), (0, pad), (0, 0)))
    v = jnp.pad(v, ((0, 0), (0, 0), (0, pad), (0, 0)))
    k_blocks = k.reshape(B, N_HEADS, nb, MOBA_BLOCK, HEAD_DIM)
    v_blocks = v.reshape(B, N_HEADS, nb, MOBA_BLOCK, HEAD_DIM)
    k_mean = jnp.mean(k_blocks.astype(jnp.float32), axis=3)
    return k_blocks, v_blocks, k_mean


def moba_attention(q, k_blocks, v_blocks, k_mean):
    B, H, S, hd = q.shape
    nb = k_blocks.shape[2]
    nc = S // Q_CHUNK
    n_sel = min(MOBA_TOPK, nb)
    scale = hd ** -0.5
    q_chunks = q.reshape(B, H, nc, Q_CHUNK, hd).transpose(2, 0, 1, 3, 4)
    bi = jnp.arange(B)[:, None, None]
    hi = jnp.arange(H)[None, :, None]
    blk_ids = jnp.arange(nb)

    def one_chunk(args):
        c, qc = args
        q0 = c * Q_CHUNK
        j = q0 // MOBA_BLOCK
        qf = qc.astype(jnp.float32)
        gate = jnp.einsum('bhqd,bhnd->bhqn', qf, k_mean)
        gate = jnp.where((blk_ids < j)[None, None, None, :], gate, NEG_INF)
        _, sel = lax.top_k(gate, n_sel)
        valid = sel < j
        idx = sel.reshape(B, H, Q_CHUNK * n_sel)
        k_sel = k_blocks[bi, hi, idx].reshape(B, H, Q_CHUNK, n_sel, MOBA_BLOCK, hd)
        v_sel = v_blocks[bi, hi, idx].reshape(B, H, Q_CHUNK, n_sel, MOBA_BLOCK, hd)
        s_sel = jnp.einsum('bhqd,bhqnld->bhqnl', qf, k_sel.astype(jnp.float32)) * scale
        s_sel = jnp.where(valid[..., None], s_sel, NEG_INF)
        s_sel = s_sel.reshape(B, H, Q_CHUNK, n_sel * MOBA_BLOCK)
        k_cur = lax.dynamic_index_in_dim(k_blocks, j, axis=2, keepdims=False)
        v_cur = lax.dynamic_index_in_dim(v_blocks, j, axis=2, keepdims=False)
        s_cur = jnp.einsum('bhqd,bhld->bhql', qf, k_cur.astype(jnp.float32)) * scale
        qpos = q0 + jnp.arange(Q_CHUNK)
        kpos = j * MOBA_BLOCK + jnp.arange(MOBA_BLOCK)
        s_cur = jnp.where((kpos[None, :] <= qpos[:, None])[None, None], s_cur, NEG_INF)
        probs = jax.nn.softmax(jnp.concatenate([s_sel, s_cur], axis=-1), axis=-1)
        p_sel = probs[..., :n_sel * MOBA_BLOCK].reshape(B, H, Q_CHUNK, n_sel, MOBA_BLOCK)
        p_cur = probs[..., n_sel * MOBA_BLOCK:]
        o = (jnp.einsum('bhqnl,bhqnld->bhqd', p_sel, v_sel.astype(jnp.float32))
             + jnp.einsum('bhql,bhld->bhqd', p_cur, v_cur.astype(jnp.float32)))
        return o.astype(q.dtype)

    out = lax.map(one_chunk, (jnp.arange(nc), q_chunks))
    return out.transpose(1, 0, 3, 2, 4).reshape(B, S, H * hd)


def moba_layer(xn, w_q, w_o, k_blocks, v_blocks, k_mean):
    B, S, D = xn.shape
    q = (xn @ w_q).reshape(B, S, N_HEADS, HEAD_DIM).transpose(0, 2, 1, 3)
    q = partial_rope(q, jnp.arange(S))
    return moba_attention(q, k_blocks, v_blocks, k_mean) @ w_o


def swiglu(xn, w1, w3, w2):
    return (jax.nn.silu(xn @ w1) * (xn @ w3)) @ w2


def moe_swiglu(xn, router, w1, w3, w2):
    B, S, D = xn.shape
    t = xn.reshape(B * S, D)
    logits = (t @ router).astype(jnp.float32)
    top_val, top_idx = lax.top_k(logits, TOP_K_EXPERTS)
    top_w = jax.nn.softmax(top_val, axis=-1)
    gates = jnp.sum(jax.nn.one_hot(top_idx, N_EXPERTS, dtype=jnp.float32) * top_w[..., None], axis=1)
    y = jnp.zeros((B * S, D), jnp.float32)
    for e in range(N_EXPERTS):
        y = y + gates[:, e:e + 1] * swiglu(t, w1[e], w3[e], w2[e]).astype(jnp.float32)
    return y.reshape(B, S, D).astype(xn.dtype)


def per_layer_embedding(hn, p_i, gate_w, proj_w):
    return jax.nn.sigmoid(hn @ gate_w) * (p_i @ proj_w)


def setup_inputs(seed: int = 0) -> dict:
    key = jax.random.key(seed)
    ks = jax.random.split(key, 24)
    D = D_MODEL
    f32 = jnp.float32

    def nrm(k, shape, fan_in):
        return jax.random.normal(k, shape, f32) * fan_in ** -0.5

    def gain(k, shape):
        return 1.0 + 0.05 * jax.random.normal(k, shape, f32)

    return {
        "x": jax.random.normal(ks[0], (BATCH, SEQ, D), f32),
        "p": jax.random.normal(ks[1], (DEPTH, BATCH, SEQ, PLE_DIM), f32),
        "pool_norm": gain(ks[2], (N_A_LAYERS, D)),
        "pool_w": nrm(ks[3], (N_A_LAYERS, N_POOL_GROUPS, POOL_GROUP_DIM, POOL_GROUP_DIM), POOL_GROUP_DIM),
        "pool_scale": 0.5 + 0.05 * jax.random.normal(ks[4], (N_A_LAYERS, D), f32),
        "kv_norm": gain(ks[5], (D,)),
        "w_k": nrm(ks[6], (D, D), D),
        "w_v": nrm(ks[7], (D, D), D),
        "attn_norm": gain(ks[8], (N_B_LAYERS, D)),
        "w_q": nrm(ks[9], (N_B_LAYERS, D, D), D),
        "w_o": nrm(ks[10], (N_B_LAYERS, D, D), D),
        "ffn_norm": gain(ks[11], (DEPTH, D)),
        "ffn_w1": nrm(ks[12], (N_DENSE, D, D_FF), D),
        "ffn_w3": nrm(ks[13], (N_DENSE, D, D_FF), D),
        "ffn_w2": nrm(ks[14], (N_DENSE, D_FF, D), D_FF),
        "router": nrm(ks[15], (N_MOE, D, N_EXPERTS), D),
        "exp_w1": nrm(ks[16], (N_MOE, N_EXPERTS, D, EXPERT_FF), D),
        "exp_w3": nrm(ks[17], (N_MOE, N_EXPERTS, D, EXPERT_FF), D),
        "exp_w2": nrm(ks[18], (N_MOE, N_EXPERTS, EXPERT_FF, D), EXPERT_FF),
        "ple_norm": gain(ks[19], (DEPTH, D)),
        "ple_gate": nrm(ks[20], (DEPTH, D, D), D),
        "ple_proj": nrm(ks[21], (DEPTH, PLE_DIM, D), PLE_DIM),
        "final_norm": gain(ks[22], (D,)),
    }


def reference(x, p, pool_norm, pool_w, pool_scale, kv_norm, w_k, w_v, attn_norm, w_q, w_o,
              ffn_norm, ffn_w1, ffn_w3, ffn_w2, router, exp_w1, exp_w3, exp_w2,
              ple_norm, ple_gate, ple_proj, final_norm):
    h = x
    shared = None
    for i in range(DEPTH):
        if i < N_A_LAYERS:
            h = h + pool_mixer(rms_norm(h, pool_norm[i]), pool_w[i], pool_scale[i])
        else:
            b = i - N_A_LAYERS
            if shared is None:
                shared = shared_kv(h, kv_norm, w_k, w_v)
            k_blocks, v_blocks, k_mean = shared
            h = h + moba_layer(rms_norm(h, attn_norm[b]), w_q[b], w_o[b], k_blocks, v_blocks, k_mean)
        hn = rms_norm(h, ffn_norm[i])
        if i % 2 == 0:
            d = i // 2
            h = h + swiglu(hn, ffn_w1[d], ffn_w3[d], ffn_w2[d])
        else:
            m = i // 2
            h = h + moe_swiglu(hn, router[m], exp_w1[m], exp_w3[m], exp_w2[m])
        h = h + per_layer_embedding(rms_norm(h, ple_norm[i]), p[i], ple_gate[i], ple_proj[i])
    return rms_norm(h, final_norm)
```

```cpp
#include <hip/hip_runtime.h>
#include <cstdio>
#include <cstdint>

#define LAS __attribute__((address_space(3)))
#define DI __device__ __forceinline__
typedef unsigned short bf16_t;
typedef short bf16x8 __attribute__((ext_vector_type(8)));
typedef short s16x4 __attribute__((ext_vector_type(4)));
typedef float f32x4 __attribute__((ext_vector_type(4)));
typedef float f32x2 __attribute__((ext_vector_type(2)));
typedef float f32x16 __attribute__((ext_vector_type(16)));
typedef unsigned u32x4 __attribute__((ext_vector_type(4)));
typedef unsigned u32x2 __attribute__((ext_vector_type(2)));
typedef __bf16 bf16x2_t __attribute__((ext_vector_type(2)));
typedef int i32x4 __attribute__((ext_vector_type(4)));
typedef int i32x8 __attribute__((ext_vector_type(8)));

#ifndef PROBE_DUP
#define PROBE_DUP 0
#endif
#define DUPN(id) ((PROBE_DUP == (id)) ? 2 : 1)
#ifndef FP8_FFN0
#define FP8_FFN0 0
#endif
#ifndef SELFCHECK
#define SELFCHECK 0
#endif
#ifndef SELFCHECK_TOL
#define SELFCHECK_TOL 0.03f
#endif
#ifndef I8_UP
#define I8_UP 1
#endif
#ifndef I8_QKV
#define I8_QKV 1
#endif
#ifndef I8_PLE
#define I8_PLE 2
#endif
#ifndef MK_N_LAUNCHES
#define MK_N_LAUNCHES 1
#endif

constexpr int BATCH = 2, SEQ = 16384, T = BATCH * SEQ, D = 1024, NH = 8, HD = 128, NBLK = 64;
constexpr int FF = 2816, EFF = 3584, NE = 8, PD = 256;
constexpr float EPS = 1e-6f;
constexpr float S8_H = 8.f, S8_W13 = 64.f, S8_ACT = 4.f, S8_W2 = 128.f, S8_WF2 = 64.f, S8_PO = 32.f, S8_QK = 16.f, S8_V = 16.f, S8_P = 256.f, S8_WKV = 64.f;
constexpr float SI8_H = 32.f;
constexpr float SI8_H3 = 24.f;
constexpr int ATT_C = 6;
constexpr int NCHUNK = 5;
constexpr int MAXCT = 64;

constexpr size_t MiB = (size_t)1 << 20, KiB = 1024;
constexpr size_t WS_ZERO = 0, ZERO_BYTES = 1536 * KiB;
constexpr size_t ZO_BAR = 0;
constexpr size_t ZO_WMAX = 72 * KiB;
constexpr size_t ZO_WMQKV = ZO_WMAX + 2 * 2816 * 4;
constexpr size_t ZO_WMG = ZO_WMQKV + 3 * 1024 * 4;
constexpr size_t ZO_CNT = 64 * KiB;
constexpr size_t ZO_LCNT = 128 * KiB;
constexpr size_t ZO_SQ1 = 1536 * KiB, ZO_SQ2 = 2048 * KiB, ZO_SQ3 = 2560 * KiB, ZO_SQ5 = 3072 * KiB, ZO_SQ6 = 3584 * KiB;
constexpr size_t ZO_KM = 1 * MiB;
constexpr size_t WS_ROPE = 4 * MiB;
constexpr size_t WS_TOP = 6 * MiB;
constexpr size_t WS_SLOT = 7 * MiB;
constexpr size_t WS_WS = 9 * MiB;
constexpr size_t WO_POOL = WS_WS, WO_F13 = WO_POOL + MiB / 2, WO_F2 = WO_F13 + 11 * MiB, WO_G0 = WO_F2 + 11 * MiB / 2, WO_G1 = WO_G0 + 2 * MiB,
                 WO_P0 = WO_G1 + 2 * MiB, WO_P1 = WO_P0 + MiB / 2, WO_QK = WO_P1 + MiB / 2, WO_V = WO_QK + 4 * MiB, WO_O = WO_V + 2 * MiB;
constexpr size_t WS_PB = 39 * MiB;
constexpr size_t WS_R = 71 * MiB;
constexpr size_t RG = 64 * MiB;
constexpr size_t R_A = WS_R, R_B = WS_R + RG, R_C = WS_R + 2 * RG, R_D = WS_R + 3 * RG, R_E = WS_R + 4 * RG, R_G = WS_R + 5 * RG, R_I = WS_R + 6 * RG, R_J = WS_R + 7 * RG;
constexpr size_t WS_END = WS_R + 8 * RG;
static_assert(WO_O + 2 * MiB == WS_PB, "small weight map");
constexpr size_t O_H2I8 = R_I, O_H5I8 = R_J, ZO_RS5 = ZO_SQ1;
constexpr size_t O_H3F8 = R_J, O_H1I8 = R_J, O_H1F8 = R_J, O_POOLED = R_A, O_H1B = R_B, O_PP0 = R_C, O_ACT0 = R_D, O_H2B = R_A, O_H3B = R_B;
constexpr size_t O_Q = R_A, O_K8 = R_C, O_Q8 = R_C + 32 * MiB, O_VT8 = R_D, O_LIST = R_E, O_ML = R_E + 32 * MiB, O_PO = R_G;
constexpr size_t O_H4B = R_B, O_H4F8 = R_J, O_WE13 = R_I, O_WE2 = R_E, O_ACT1 = R_C, O_Y1 = R_A, O_Y2 = R_G, O_H5B = R_B, O_PP1 = R_C, O_H6B = R_A;

constexpr int RING_BYTES = 131072;
constexpr int LDSCTL_OFF = RING_BYTES;
constexpr int MISC_OFF = LDSCTL_OFF + 320;
constexpr int TAB_OFF = LDSCTL_OFF + 1024;
constexpr int LDS_BYTES = 147456;

DI unsigned pk2(float a, float b) { f32x2 v = {a, b}; return __builtin_bit_cast(unsigned, __builtin_convertvector(v, bf16x2_t)); }
DI unsigned pk4_fp8(float a, float b, float c, float d) {
    a = __builtin_amdgcn_fmed3f(a, -448.f, 448.f); b = __builtin_amdgcn_fmed3f(b, -448.f, 448.f); c = __builtin_amdgcn_fmed3f(c, -448.f, 448.f); d = __builtin_amdgcn_fmed3f(d, -448.f, 448.f);
    unsigned w = 0u; w = (unsigned)__builtin_amdgcn_cvt_pk_fp8_f32(a, b, (int)w, false); w = (unsigned)__builtin_amdgcn_cvt_pk_fp8_f32(c, d, (int)w, true); return w; }
DI unsigned pk4_i8(float a, float b, float c, float d) {
    const int ia = (int)__builtin_rintf(__builtin_amdgcn_fmed3f(a, -127.f, 127.f)), ib = (int)__builtin_rintf(__builtin_amdgcn_fmed3f(b, -127.f, 127.f));
    const int ic = (int)__builtin_rintf(__builtin_amdgcn_fmed3f(c, -127.f, 127.f)), id = (int)__builtin_rintf(__builtin_amdgcn_fmed3f(d, -127.f, 127.f));
    return ((unsigned)ia & 255u) | (((unsigned)ib & 255u) << 8) | (((unsigned)ic & 255u) << 16) | ((unsigned)id << 24); }
DI float bf_lo(unsigned u) { return __uint_as_float(u << 16); }
DI float bf_hi(unsigned u) { return __uint_as_float(u & 0xffff0000u); }
DI float fexp2(float x) { return __builtin_amdgcn_exp2f(x); }
DI float frcp(float x) { return __builtin_amdgcn_rcpf(x); }
DI float sigmoidf_(float a) { return frcp(1.0f + fexp2(-1.4426950408889634f * a)); }
DI unsigned lds_add(LAS unsigned* p, unsigned v) { return __hip_atomic_fetch_add(p, v, __ATOMIC_RELAXED, __HIP_MEMORY_SCOPE_WORKGROUP); }
DI int lane_id() { int r; asm volatile("v_mbcnt_lo_u32_b32 %0, -1, 0\n\tv_mbcnt_hi_u32_b32 %0, -1, %0" : "=v"(r)); return r; }
DI float wave_sum(float v) { v += __shfl_xor(v, 32); v += __shfl_xor(v, 16); v += __shfl_xor(v, 8); v += __shfl_xor(v, 4); v += __shfl_xor(v, 2); v += __shfl_xor(v, 1); return v; }

#define XB_TMO      128
#define XB_XCNT(j)  (256  + 64 * (j))
#define XB_XSUB(j)  (1280 + 64 * (j))
#define XB_XGEN(j)  (2304 + 64 * (j))
#define XB_TOP      3328
#define XB_TOPGEN   3392
#define XCD_BAR_WORDS 3456
#define XB_SPIN_CAP (1u << 18)
__device__ __forceinline__ unsigned xb_ld(unsigned* p)              { return __hip_atomic_load(p, __ATOMIC_RELAXED, __HIP_MEMORY_SCOPE_AGENT); }
__device__ __forceinline__ unsigned xb_add(unsigned* p, unsigned v) { return __hip_atomic_fetch_add(p, v, __ATOMIC_RELAXED, __HIP_MEMORY_SCOPE_AGENT); }
__device__ __forceinline__ unsigned xb_xcc_id() { return (unsigned)__builtin_amdgcn_s_getreg((3 << 11) | 20) & 0xFu; }
#define XB_SPIN(cond, bar) do { unsigned _sp = 0; while (cond) { __builtin_amdgcn_s_sleep(1); \
    if ((++_sp & 255u) == 0u) { if (xb_ld(&(bar)[XB_TMO])) break; if (_sp > XB_SPIN_CAP) { atomicAdd(&(bar)[XB_TMO], 1u); break; } } } } while (0)
struct XcdBarrier { unsigned* bar; unsigned x; volatile LAS unsigned* st; };
__device__ __forceinline__ XcdBarrier xcd_barrier_post(unsigned* bar, volatile LAS unsigned* st, bool leader) {
    XcdBarrier b; b.bar = bar; b.x = xb_xcc_id(); b.st = st;
    if (leader) (void)xb_add(&bar[XB_XCNT(b.x)], 1u);
    return b;
}
__device__ __forceinline__ void xcd_barrier_complete(unsigned* bar, unsigned x, unsigned& nloc, unsigned& nx) {
    const unsigned G = gridDim.x * gridDim.y * gridDim.z;
    unsigned sum, cnt, mine, sp = 0u;
    for (;;) {
        sum = 0u; cnt = 0u; mine = 0u;
#pragma unroll
        for (unsigned j = 0; j < 16; ++j) { const unsigned c = xb_ld(&bar[XB_XCNT(j)]); sum += c; cnt += (c > 0u) ? 1u : 0u; mine = (j == x) ? c : mine; }
        if (sum == G) break;
        __builtin_amdgcn_s_sleep(1);
        if ((++sp & 255u) == 0u) { if (xb_ld(&bar[XB_TMO])) break; if (sp > XB_SPIN_CAP) { atomicAdd(&bar[XB_TMO], 1u); break; } }
    }
    nloc = mine > 0u ? mine : 1u; nx = cnt > 0u ? cnt : 1u;
}
__device__ __forceinline__ void xcd_barrier(const XcdBarrier& b, bool leader) {
    asm volatile("s_waitcnt vmcnt(0)" ::: "memory");
    __syncthreads();
    if (leader) {
        unsigned* bar = b.bar;
        __builtin_amdgcn_s_waitcnt(0);
        unsigned nloc = b.st[0], nx = b.st[1];
        if (nloc == 0u) { xcd_barrier_complete(bar, b.x, nloc, nx); b.st[0] = nloc; b.st[1] = nx; }
        const unsigned old = xb_add(&bar[XB_XSUB(b.x)], 1u);
        const unsigned gen = old / nloc;
        if (old + 1u == (gen + 1u) * nloc) {
            __builtin_amdgcn_fence(__ATOMIC_RELEASE, "agent");
            asm volatile("s_waitcnt vmcnt(0)" ::: "memory");
            const unsigned og = xb_add(&bar[XB_TOP], 1u);
            const unsigned tg = og / nx;
            if (og + 1u == (tg + 1u) * nx) xb_add(&bar[XB_TOPGEN], 1u);
            else XB_SPIN(xb_ld(&bar[XB_TOPGEN]) == tg, bar);
            __builtin_amdgcn_fence(__ATOMIC_ACQUIRE, "agent");
            xb_add(&bar[XB_XGEN(b.x)], 1u);
            asm volatile("s_waitcnt vmcnt(0)" ::: "memory");
        } else {
            XB_SPIN(xb_ld(&bar[XB_XGEN(b.x)]) == gen, bar);
            __builtin_amdgcn_fence(__ATOMIC_ACQUIRE, "agent");
            asm volatile("s_waitcnt vmcnt(0)" ::: "memory");
        }
    }
    __syncthreads();
}

namespace pg8 {
constexpr int BM = 256, BK = 64, HALF = 128, HTB = HALF * BK * 2, NXCD = 8, WGM = 8;
__host__ __device__ __forceinline__ int lds_byte(int r, int c) { const int st = (r >> 4) * 2 + (c >> 5), rr = r & 15, cc = c & 31, ob = rr * 64 + cc * 2; return st * 1024 + (ob ^ (((ob >> 9) & 1) << 5)); }
__host__ __device__ __forceinline__ void stage_rc(int b, int& R, int& C) { const int st = b / 1024, sb = b % 1024, swz = sb ^ (((sb >> 9) & 1) << 5); R = (st >> 1) * 16 + swz / 64; C = (st & 1) * 32 + (swz % 64) / 2; }
__host__ __device__ __forceinline__ int perm32(int rho) { const int n = rho >> 4, i = rho & 15; return 8 * (i >> 2) + 4 * n + (i & 3); }

struct Unit { int pm, pn, arow, brow; };
struct Gemm { const bf16_t* A; const bf16_t* Bt; int K; const int* rowidx; int wv; };

struct TileOrder {
    int nM, nN, nwg, G, c;
    __device__ void init(int nM_, int nN_, int G_, int c_) { nM = nM_; nN = nN_; nwg = nM * nN; G = G_; c = c_; }
    __device__ bool tile(int i, int& pm, int& pn) const {
        const long L = (long)i * G + c; if (L >= nwg) return false;
        int wgid = (int)L; { const int q = nwg / NXCD, r = nwg % NXCD, xcd = wgid % NXCD, off = wgid / NXCD; wgid = (xcd < r ? xcd * (q + 1) : r * (q + 1) + (xcd - r) * q) + off; }
        const int nig = WGM * nN, gid = wgid / nig, fm = gid * WGM, gsz = (nM - fm) < WGM ? (nM - fm) : WGM;
        pm = fm + ((wgid % nig) % gsz); pn = (wgid % nig) / gsz; return true;
    }
};
struct OrdStd : TileOrder {
    __device__ bool next(int i, Unit& u) const { int pm, pn; if (!tile(i, pm, pn)) return false; u.pm = pm; u.pn = pn; u.arow = pm * BM; u.brow = pn * BM; return true; }
};
struct OrdPool : TileOrder {
    __device__ bool next(int i, Unit& u) const { int pm, pn; if (!tile(i, pm, pn)) return false; u.pm = pm; u.pn = pn; u.arow = pn * T + pm * BM; u.brow = pn * BM; return true; }
};
struct OrdMoE {
    int t0, ntc, npn, nb, nxc, xcd, rank, brow_e, second, light; const LAS int* cumt;
    __device__ __forceinline__ void init(int t0_, int ntc_, int npn_, int G, int c, int brow_e_, int second_, const LAS int* cumt_, int light_xcds = 0) {
        t0 = t0_; ntc = ntc_; npn = npn_; brow_e = brow_e_; second = second_; cumt = cumt_;
        if (G % 8 == 0) { nxc = 8; nb = G / 8; xcd = c % 8; rank = c / 8; } else { nxc = 1; nb = G; xcd = 0; rank = c; }
        light = (nxc == 8 && nb == 32 && xcd < light_xcds) ? 1 : 0;
    }
    __device__ __forceinline__ bool next(int i, Unit& u) const {
        const int nx = (ntc > xcd) ? (ntc - xcd + nxc - 1) / nxc : 0;
        const int nu = nx * npn;
        long j;
        if (light && nu == 224) {
            const int start = (rank < 4) ? 4 * rank : (rank < 16) ? 16 + 8 * (rank - 4) : 112 + 7 * (rank - 16);
            const int cnt = (rank < 4) ? 4 : (rank < 16) ? 8 : 7;
            if (i >= cnt) return false;
            j = start + i;
        } else { j = (long)i * nb + rank; if (j >= (long)nu) return false; }
        const int tlx = (int)(j % nx), pn = (int)(j / nx), tl = xcd + nxc * tlx, tile = t0 + tl;
        int e = 0;
#pragma unroll
        for (int k = 1; k < 8; ++k) e += (tile >= cumt[k]) ? 1 : 0;
        u.pn = pn; u.brow = e * brow_e + pn * BM;
        if (second) { u.pm = tile; u.arow = tl * BM; } else { u.pm = tl; u.arow = tile * BM; }
        return true;
    }
};

template <class Epi, class Sched, bool GATHER, bool FP8 = false, bool I8 = false>
__device__ __forceinline__ void gemm_phase(LAS unsigned char* lds, const Gemm g, const Sched& S, const Epi& E) {
    int wvv = g.wv; asm volatile("" : "+s"(wvv));
    int tid = wvv * 64 + lane_id(); asm volatile("" : "+v"(tid));
    const int wid = __builtin_amdgcn_readfirstlane(tid >> 6), lane = tid & 63, wr = wid >> 2, wc = wid & 3, fr = lane & 15, fq = lane >> 4;
    int K = g.K; asm volatile("" : "+s"(K)); const int nt = K / BK;
    unsigned voffA[2], voffB[2]; int RA[2]; unsigned CA[2];
#pragma unroll
    for (int i = 0; i < 2; ++i) { int R, C; stage_rc(tid * 16 + i * 8192, R, C); const int Rb = (R & ~31) + perm32(R & 31);
        voffA[i] = (unsigned)(R * K + C) * 2u; voffB[i] = (unsigned)(Rb * K + C) * 2u; RA[i] = R; CA[i] = (unsigned)C * 2u; }
    const size_t kstep = (size_t)(BK * 2);
    const size_t hstep = (size_t)HALF * K * 2;
    const unsigned hstepu = (unsigned)(HALF * K * 2);
    const size_t rstep = (size_t)K * 2;
    const unsigned ldsw = (unsigned)wid * 1024u;
    const int aoff = lds_byte(wr * 64 + fr, fq * 8), boff = lds_byte(wc * 32 + fr, fq * 8);
#define PG8_SA(b, h) (((b) * 2 + (h)) * HTB)
#define PG8_SB(b, h) ((4 + (b) * 2 + (h)) * HTB)
#define PG8_STAGE(bufoff, gbase, voff) do { _Pragma("unroll") for (int _i = 0; _i < 2; ++_i) \
        __builtin_amdgcn_global_load_lds((const unsigned*)((const char*)(gbase) + (voff)[_i]), (LAS unsigned*)(lds + (bufoff) + ldsw + _i * 8192), 16, 0, 0); } while (0)
#define PG8_CAT(a, b) __builtin_shufflevector(a, b, 0, 1, 2, 3, 4, 5, 6, 7)
#define PG8_LO(v) __builtin_bit_cast(bf16x8, __builtin_shufflevector(v, v, 0, 1, 2, 3))
#define PG8_HI(v) __builtin_bit_cast(bf16x8, __builtin_shufflevector(v, v, 4, 5, 6, 7))
#define PG8_LDA(dst, b, h) do { _Pragma("unroll") for (int m = 0; m < 4; ++m) dst[m] = PG8_CAT(*(const LAS i32x4*)(lds + PG8_SA(b, h) + aoff + m * 2048), *(const LAS i32x4*)(lds + PG8_SA(b, h) + aoff + m * 2048 + 1024)); } while (0)
#define PG8_LDB(dst, b, h) do { _Pragma("unroll") for (int n = 0; n < 2; ++n) dst[n] = PG8_CAT(*(const LAS i32x4*)(lds + PG8_SB(b, h) + boff + n * 2048), *(const LAS i32x4*)(lds + PG8_SB(b, h) + boff + n * 2048 + 1024)); } while (0)
#define PG8_MMAZ(ai, bj, At, Bt, Z) do { __builtin_amdgcn_s_setprio(1); \
        if constexpr (FP8) { _Pragma("unroll") for (int m = 0; m < 4; ++m) _Pragma("unroll") for (int n = 0; n < 2; ++n) { \
            if constexpr (Z) asm volatile("v_mfma_scale_f32_16x16x128_f8f6f4 %0, %1, %2, 0, %3, %3 op_sel_hi:[0,0,0]" : "=&v"(acc[ai][bj][m][n]) : "v"(Bt[n]), "v"(At[m]), "v"(one_e8m0)); \
            else asm volatile("v_mfma_scale_f32_16x16x128_f8f6f4 %0, %1, %2, %0, %3, %3 op_sel_hi:[0,0,0]" : "+v"(acc[ai][bj][m][n]) : "v"(Bt[n]), "v"(At[m]), "v"(one_e8m0)); } } \
        else if constexpr (I8) { \
            _Pragma("unroll") for (int m = 0; m < 4; ++m) _Pragma("unroll") for (int n = 0; n < 2; ++n) { \
                if constexpr (Z) asm volatile("v_mfma_i32_16x16x64_i8 %0, %1, %2, 0" : "=&v"(acc[ai][bj][m][n]) : "v"(__builtin_shufflevector(Bt[n], Bt[n], 0, 1, 2, 3)), "v"(__builtin_shufflevector(At[m], At[m], 0, 1, 2, 3))); \
                else asm volatile("v_mfma_i32_16x16x64_i8 %0, %1, %2, %0" : "+v"(acc[ai][bj][m][n]) : "v"(__builtin_shufflevector(Bt[n], Bt[n], 0, 1, 2, 3)), "v"(__builtin_shufflevector(At[m], At[m], 0, 1, 2, 3))); } \
            _Pragma("unroll") for (int m = 0; m < 4; ++m) _Pragma("unroll") for (int n = 0; n < 2; ++n) \
                asm volatile("v_mfma_i32_16x16x64_i8 %0, %1, %2, %0" : "+v"(acc[ai][bj][m][n]) : "v"(__builtin_shufflevector(Bt[n], Bt[n], 4, 5, 6, 7)), "v"(__builtin_shufflevector(At[m], At[m], 4, 5, 6, 7))); } \
        else {   \
            _Pragma("unroll") for (int m = 0; m < 4; ++m) _Pragma("unroll") for (int n = 0; n < 2; ++n) { \
                if constexpr (Z) asm volatile("v_mfma_f32_16x16x32_bf16 %0, %1, %2, 0" : "=&v"(acc[ai][bj][m][n]) : "v"(PG8_LO(Bt[n])), "v"(PG8_LO(At[m]))); \
                else asm volatile("v_mfma_f32_16x16x32_bf16 %0, %1, %2, %0" : "+v"(acc[ai][bj][m][n]) : "v"(PG8_LO(Bt[n])), "v"(PG8_LO(At[m]))); } \
            _Pragma("unroll") for (int m = 0; m < 4; ++m) _Pragma("unroll") for (int n = 0; n < 2; ++n) \
                asm volatile("v_mfma_f32_16x16x32_bf16 %0, %1, %2, %0" : "+v"(acc[ai][bj][m][n]) : "v"(PG8_HI(Bt[n])), "v"(PG8_HI(At[m]))); } \
        __builtin_amdgcn_s_setprio(0); } while (0)
#define PG8_WAIT_V(n) asm volatile("s_waitcnt vmcnt(" #n ")" ::: "memory")
#define PG8_WAIT_L(n) asm volatile("s_waitcnt lgkmcnt(" #n ")" ::: "memory")
#define PG8_BAR __builtin_amdgcn_s_barrier()
#define PG8_SCHED __builtin_amdgcn_sched_barrier(0)
#define PG8_AOFF(u, v0, v1) do { if constexpr (GATHER) { _Pragma("unroll") for (int _i = 0; _i < 2; ++_i) { \
            const unsigned r0 = (unsigned)g.rowidx[(u).arow + RA[_i]], r1 = (unsigned)g.rowidx[(u).arow + HALF + RA[_i]]; \
            v0[_i] = r0 * (unsigned)(K * 2) + CA[_i]; v1[_i] = r1 * (unsigned)(K * 2) + CA[_i]; } } \
        else { _Pragma("unroll") for (int _i = 0; _i < 2; ++_i) { v0[_i] = voffA[_i]; v1[_i] = voffA[_i] + hstepu; } } } while (0)
#define PG8_ABASE(u) (GATHER ? (const char*)g.A : (const char*)g.A + (size_t)(u).arow * rstep)
    Unit cur, nxt; int ui = 0;
    if (!S.next(0, cur)) return;
    f32x4 acc[2][2][4][2];
#define PG8_CLEAR() do { if constexpr (false) { _Pragma("unroll") for (int a = 0; a < 2; ++a) _Pragma("unroll") for (int b = 0; b < 2; ++b) _Pragma("unroll") for (int m = 0; m < 4; ++m) _Pragma("unroll") for (int n = 0; n < 2; ++n) \
        acc[a][b][m][n] = (f32x4){0.f, 0.f, 0.f, 0.f}; } } while (0)
    PG8_CLEAR();
    i32x8 At[4], B0[2], B1[2];
    const int one_e8m0 = 0x7F7F7F7F; (void)one_e8m0;
    unsigned cv0[2], cv1[2], nv0[2], nv1[2];
    PG8_AOFF(cur, cv0, cv1);
    const char* cA = PG8_ABASE(cur); const char* cB = (const char*)g.Bt + (size_t)cur.brow * rstep;
    PG8_STAGE(PG8_SB(0, 0), cB, voffB); PG8_STAGE(PG8_SB(0, 1), cB + hstep, voffB); PG8_STAGE(PG8_SA(0, 0), cA, cv0); PG8_STAGE(PG8_SA(0, 1), cA, cv1);
    if (wr == 1) PG8_BAR;
    PG8_WAIT_V(2); PG8_BAR;
    PG8_STAGE(PG8_SB(1, 0), cB + kstep, voffB); PG8_STAGE(PG8_SA(1, 0), cA + kstep, cv0); PG8_STAGE(PG8_SB(1, 1), cB + hstep + kstep, voffB);
    PG8_WAIT_V(6); PG8_BAR;
    for (;;) {
        const bool has_next = S.next(ui + 1, nxt);
        const char* nA = cA; const char* nB = cB;
#pragma unroll
        for (int i = 0; i < 2; ++i) { nv0[i] = cv0[i]; nv1[i] = cv1[i]; }
        if (has_next) { nA = PG8_ABASE(nxt); nB = (const char*)g.Bt + (size_t)nxt.brow * rstep; PG8_AOFF(nxt, nv0, nv1); }
#define PG8_KITER(t, Z) do { \
            const bool last = ((t) == nt - 2); \
            const char* a1 = cA + (size_t)((t) + 1) * kstep; \
            const char* a2 = last ? nA : cA + (size_t)((t) + 2) * kstep; const char* b2 = last ? nB : cB + (size_t)((t) + 2) * kstep; \
            const char* a3 = a2 + kstep; const char* b3 = b2 + kstep; \
            unsigned s0[2], s1[2]; \
            _Pragma("unroll") for (int i = 0; i < 2; ++i) { s0[i] = last ? nv0[i] : cv0[i]; s1[i] = last ? nv1[i] : cv1[i]; } \
              \
            PG8_LDB(B0, 0, 0); PG8_LDB(B1, 0, 1); PG8_SCHED; PG8_LDA(At, 0, 0); PG8_STAGE(PG8_SA(1, 1), a1, cv1); \
            PG8_WAIT_V(8); PG8_WAIT_L(0); PG8_BAR; PG8_MMAZ(0, 0, At, B0, Z); PG8_MMAZ(0, 1, At, B1, Z); PG8_BAR; PG8_SCHED; \
              \
            PG8_LDA(At, 0, 1); PG8_STAGE(PG8_SB(0, 0), b2, voffB); PG8_STAGE(PG8_SB(0, 1), b2 + hstep, voffB); PG8_STAGE(PG8_SA(0, 0), a2, s0); \
            PG8_WAIT_V(8); PG8_WAIT_L(0); PG8_BAR; PG8_MMAZ(1, 0, At, B0, Z); PG8_MMAZ(1, 1, At, B1, Z); PG8_BAR; PG8_SCHED; \
              \
            PG8_LDB(B0, 1, 0); PG8_LDB(B1, 1, 1); PG8_SCHED; PG8_LDA(At, 1, 0); PG8_STAGE(PG8_SA(0, 1), a2, s1); \
            PG8_WAIT_V(8); PG8_WAIT_L(0); PG8_BAR; PG8_MMAZ(0, 0, At, B0, false); PG8_MMAZ(0, 1, At, B1, false); PG8_BAR; PG8_SCHED; \
              \
            PG8_LDA(At, 1, 1); PG8_STAGE(PG8_SB(1, 0), b3, voffB); PG8_STAGE(PG8_SB(1, 1), b3 + hstep, voffB); PG8_STAGE(PG8_SA(1, 0), a3, s0); \
            PG8_WAIT_V(8); PG8_WAIT_L(0); PG8_BAR; PG8_MMAZ(1, 0, At, B0, false); PG8_MMAZ(1, 1, At, B1, false); PG8_BAR; PG8_SCHED; \
        } while (0)
        PG8_KITER(0, true);
        for (int t = 2; t < nt; t += 2) PG8_KITER(t, false);
        asm volatile("s_nop 7\n\ts_nop 7\n\ts_nop 7" ::: "memory");
        if (wr == 0) PG8_BAR;
        E(acc, cur, wr, wc, fr, fq);
        if (!has_next) break;
        PG8_CLEAR();
        cur = nxt; cA = nA; cB = nB; ++ui;
#pragma unroll
        for (int i = 0; i < 2; ++i) { cv0[i] = nv0[i]; cv1[i] = nv1[i]; }
        if (wr == 1) PG8_BAR;
    }
    PG8_WAIT_V(0);
    PG8_BAR;
#undef PG8_SA
#undef PG8_SB
#undef PG8_STAGE
#undef PG8_LDA
#undef PG8_LDB
#undef PG8_MMAZ
#undef PG8_KITER
#undef PG8_CLEAR
#undef PG8_CAT
#undef PG8_LO
#undef PG8_HI
#undef PG8_WAIT_V
#undef PG8_WAIT_L
#undef PG8_BAR
#undef PG8_SCHED
#undef PG8_AOFF
#undef PG8_ABASE
}

typedef f32x4 Acc[2][2][4][2];

DI void sq_store(LAS float* part, float* sq, const Unit& u, int wr, int wc, int fr, int fq) {
    asm volatile("s_waitcnt lgkmcnt(0)" ::: "memory"); __builtin_amdgcn_s_barrier(); asm volatile("" ::: "memory");
    const int t = (wr * 4 + wc) * 64 + fq * 16 + fr;
    if (t < 256) { const f32x4 p = *(const LAS f32x4*)(part + t * 4); sq[(size_t)(u.pm * BM + t) * 4 + u.pn] = (p[0] + p[1]) + (p[2] + p[3]); }
}
DI float sq_rstd(const float* sq, int row) { const f32x4 p = *(const f32x4*)(sq + (size_t)row * 4); return __builtin_amdgcn_rsqf(((p[0] + p[1]) + (p[2] + p[3])) * (1.0f / D) + EPS); }

DI f32x4 cvt4i(const f32x4& v) { return (f32x4){(float)__float_as_int(v[0]), (float)__float_as_int(v[1]), (float)__float_as_int(v[2]), (float)__float_as_int(v[3])}; }
template <bool RIN_BF16> struct EpiResid {
    const void* rin; bf16_t* hb; float* sq; LAS float* part; unsigned char* h8; unsigned char* hi8; float ascale, si8;
    DI void operator()(const Acc& acc, const Unit& u, int wr, int wc, int fr, int fq) const {
        const int row0 = u.pm * BM + wr * 64 + fr, col0 = u.pn * BM + wc * 32 + 8 * fq;
#pragma unroll
        for (int ai = 0; ai < 2; ++ai) {
            f32x4 ra[4][2], rb[4][2];
#pragma unroll
            for (int m = 0; m < 4; ++m) { const size_t base = (size_t)(row0 + ai * HALF + m * 16) * D + col0;
#pragma unroll
                for (int bj = 0; bj < 2; ++bj) {
                    if constexpr (RIN_BF16) { const u32x4 rw = *(const u32x4*)((const bf16_t*)rin + base + bj * HALF);
                        ra[m][bj] = (f32x4){bf_lo(rw.x), bf_hi(rw.x), bf_lo(rw.y), bf_hi(rw.y)}; rb[m][bj] = (f32x4){bf_lo(rw.z), bf_hi(rw.z), bf_lo(rw.w), bf_hi(rw.w)}; }
                    else { const float* rp = (const float*)rin + base + bj * HALF; ra[m][bj] = *(const f32x4*)rp; rb[m][bj] = *(const f32x4*)(rp + 4); } } }
#pragma unroll
            for (int m = 0; m < 4; ++m) {
                const int row = row0 + ai * HALF + m * 16; const size_t base = (size_t)row * D + col0; float ss = 0.f;
#pragma unroll
                for (int bj = 0; bj < 2; ++bj) {
                    const f32x4 a = ra[m][bj] + acc[ai][bj][m][0] * ascale, b = rb[m][bj] + acc[ai][bj][m][1] * ascale;
                    { u32x4 w; w.x = pk2(a[0], a[1]); w.y = pk2(a[2], a[3]); w.z = pk2(b[0], b[1]); w.w = pk2(b[2], b[3]); *(u32x4*)(hb + base + bj * HALF) = w; }
                    if (h8) { u32x2 w; w.x = pk4_fp8(a[0] * S8_H, a[1] * S8_H, a[2] * S8_H, a[3] * S8_H); w.y = pk4_fp8(b[0] * S8_H, b[1] * S8_H, b[2] * S8_H, b[3] * S8_H); *(u32x2*)(h8 + base + bj * HALF) = w; }
                    if (hi8) *(u32x2*)(hi8 + base + bj * HALF) = (u32x2){pk4_i8(a[0] * si8, a[1] * si8, a[2] * si8, a[3] * si8), pk4_i8(b[0] * si8, b[1] * si8, b[2] * si8, b[3] * si8)};
                    ss += (a[0] * a[0] + a[1] * a[1]) + (a[2] * a[2] + a[3] * a[3]) + (b[0] * b[0] + b[1] * b[1]) + (b[2] * b[2] + b[3] * b[3]);
                }
                if (sq) { ss += __shfl_xor(ss, 16); ss += __shfl_xor(ss, 32); if (fq == 0) part[(wr * 64 + fr + ai * HALF + m * 16) * 4 + wc] = ss; }
            }
        }
        if (sq) sq_store(part, sq, u, wr, wc, fr, fq);
    }
};

template <bool RS_IS_SQ, bool FP8OUT = false, bool ACCI8 = false> struct EpiSwiGLU {
    bf16_t* out; int ldo; const float* rs; float ascale; const float* wmax;
    DI void operator()(const Acc& acc, const Unit& u, int wr, int wc, int fr, int fq) const {
        const int lr0 = wr * 64 + fr;
        f32x4 dq0[2], dq1[2];
        if constexpr (ACCI8) { const int c0 = u.pn * HALF + wc * 32 + 8 * fq;
#pragma unroll
            for (int n = 0; n < 2; ++n) { dq0[n] = *(const f32x4*)(wmax + c0 + 4 * n) * (1.0f / 127.0f); dq1[n] = *(const f32x4*)(wmax + FF + c0 + 4 * n) * (1.0f / 127.0f); } }
        float rvs[2][4];
#pragma unroll
        for (int ai = 0; ai < 2; ++ai)
#pragma unroll
            for (int m = 0; m < 4; ++m) { const int lr = lr0 + ai * HALF + m * 16; rvs[ai][m] = (RS_IS_SQ ? sq_rstd(rs, u.arow + lr) : rs[u.arow + lr]) * ascale; }
#pragma unroll
        for (int ai = 0; ai < 2; ++ai)
#pragma unroll
            for (int m = 0; m < 4; ++m) {
                const int lr = lr0 + ai * HALF + m * 16;
                const float rv = rvs[ai][m];
                const float rvo = FP8OUT ? rv * S8_ACT : rv, rvn = rv * -1.4426950408889634f;
                float gv[8];
#pragma unroll
                for (int n = 0; n < 2; ++n)
#pragma unroll
                    for (int e2 = 0; e2 < 2; ++e2) {
                        f32x2 x0 = {acc[ai][0][m][n][2 * e2], acc[ai][0][m][n][2 * e2 + 1]}, x1 = {acc[ai][1][m][n][2 * e2], acc[ai][1][m][n][2 * e2 + 1]};
                        if constexpr (ACCI8) { x0 = (f32x2){(float)__float_as_int(x0.x) * dq0[n][2 * e2], (float)__float_as_int(x0.y) * dq0[n][2 * e2 + 1]};
                                               x1 = (f32x2){(float)__float_as_int(x1.x) * dq1[n][2 * e2], (float)__float_as_int(x1.y) * dq1[n][2 * e2 + 1]}; }
                        const f32x2 t = x0 * rvn, ab = (x0 * rvo) * (x1 * rv);
                        f32x2 d; d.x = fexp2(t.x); d.y = fexp2(t.y); d = d + 1.0f;
                        f32x2 r; r.x = frcp(d.x); r.y = frcp(d.y);
                        const f32x2 g = ab * r;
                        gv[n * 4 + 2 * e2] = g.x; gv[n * 4 + 2 * e2 + 1] = g.y;
                    }
                if constexpr (FP8OUT) {
                    u32x2 w; w.x = pk4_fp8(gv[0], gv[1], gv[2], gv[3]); w.y = pk4_fp8(gv[4], gv[5], gv[6], gv[7]);
                    *(u32x2*)((unsigned char*)out + (size_t)(u.pm * BM + lr) * ldo + u.pn * HALF + wc * 32 + 8 * fq) = w;
                } else {
                    u32x4 w; w.x = pk2(gv[0], gv[1]); w.y = pk2(gv[2], gv[3]); w.z = pk2(gv[4], gv[5]); w.w = pk2(gv[6], gv[7]);
                    *(u32x4*)(out + (size_t)(u.pm * BM + lr) * ldo + u.pn * HALF + wc * 32 + 8 * fq) = w;
                }
            }
    }
};

template <bool I8COPY = false, bool ACCI8 = false, bool ROWSC = false> struct EpiPLE {
    const bf16_t* hin; const bf16_t* pp; bf16_t* hout; float* sqout; const float* sqin; LAS float* part; unsigned char* h8; const float* wmax; const float* rsc;
    DI void operator()(Acc& acc, const Unit& u, int wr, int wc, int fr, int fq) const {
        const int row0 = u.pm * BM + wr * 64 + fr, col0 = u.pn * BM + wc * 32 + 8 * fq;
        constexpr int NB = ACCI8 ? 3 : 2;
#pragma unroll
        for (int bt = 0; bt < NB; ++bt) {
            const int ai = ACCI8 ? (bt >> 1) : bt, mb = (ACCI8 && bt == 1) ? 2 : 0, mc = (ACCI8 && bt < 2) ? 2 : 4;
            if constexpr (ACCI8) {
                float rr[4];
#pragma unroll
                for (int m = 0; m < 4; ++m) if (m < mc) { const int row = row0 + ai * HALF + (mb + m) * 16; rr[m] = ROWSC ? rsc[row] : sq_rstd(sqin, row) * (1.0f / SI8_H3); }
#pragma unroll
                for (int bj = 0; bj < 2; ++bj)
#pragma unroll
                    for (int n = 0; n < 2; ++n) { const f32x4 dq = *(const f32x4*)(wmax + col0 + bj * HALF + 4 * n) * (1.0f / 127.0f);
#pragma unroll
                        for (int m = 0; m < 4; ++m) if (m < mc) acc[ai][bj][mb + m][n] = cvt4i(acc[ai][bj][mb + m][n]) * (dq * rr[m]); }
                __builtin_amdgcn_sched_barrier(0); }
            u32x4 pws[4][2], hws[4][2]; float rvs[4];
#pragma unroll
            for (int m = 0; m < 4; ++m) if (m < mc) { const int row = row0 + ai * HALF + (mb + m) * 16; const size_t base = (size_t)row * D + col0; rvs[m] = ACCI8 ? 1.f : sq_rstd(sqin, row);
#pragma unroll
                for (int bj = 0; bj < 2; ++bj) { pws[m][bj] = *(const u32x4*)(pp + base + bj * HALF); hws[m][bj] = *(const u32x4*)(hin + base + bj * HALF); } }
#pragma unroll
            for (int m = 0; m < 4; ++m) if (m < mc) {
                const int row = row0 + ai * HALF + (mb + m) * 16; const size_t base = (size_t)row * D + col0; float ss = 0.f;
                const float rv = rvs[m];
#pragma unroll
                for (int bj = 0; bj < 2; ++bj) {
                    const u32x4 pw = pws[m][bj], hw = hws[m][bj];
                    f32x4 a = (f32x4){bf_lo(hw.x), bf_hi(hw.x), bf_lo(hw.y), bf_hi(hw.y)}, b = (f32x4){bf_lo(hw.z), bf_hi(hw.z), bf_lo(hw.w), bf_hi(hw.w)};
                    const f32x4 g0 = acc[ai][bj][mb + m][0] * rv, g1 = acc[ai][bj][mb + m][1] * rv;
                    a[0] += sigmoidf_(g0[0]) * bf_lo(pw.x); a[1] += sigmoidf_(g0[1]) * bf_hi(pw.x); a[2] += sigmoidf_(g0[2]) * bf_lo(pw.y); a[3] += sigmoidf_(g0[3]) * bf_hi(pw.y);
                    b[0] += sigmoidf_(g1[0]) * bf_lo(pw.z); b[1] += sigmoidf_(g1[1]) * bf_hi(pw.z); b[2] += sigmoidf_(g1[2]) * bf_lo(pw.w); b[3] += sigmoidf_(g1[3]) * bf_hi(pw.w);
                    { u32x4 w; w.x = pk2(a[0], a[1]); w.y = pk2(a[2], a[3]); w.z = pk2(b[0], b[1]); w.w = pk2(b[2], b[3]); *(u32x4*)(hout + base + bj * HALF) = w; }
                    if (h8) { if constexpr (I8COPY) *(u32x2*)(h8 + base + bj * HALF) = (u32x2){pk4_i8(a[0] * SI8_H3, a[1] * SI8_H3, a[2] * SI8_H3, a[3] * SI8_H3), pk4_i8(b[0] * SI8_H3, b[1] * SI8_H3, b[2] * SI8_H3, b[3] * SI8_H3)};
                              else *(u32x2*)(h8 + base + bj * HALF) = (u32x2){pk4_fp8(a[0] * S8_H, a[1] * S8_H, a[2] * S8_H, a[3] * S8_H), pk4_fp8(b[0] * S8_H, b[1] * S8_H, b[2] * S8_H, b[3] * S8_H)}; }
                    ss += (a[0] * a[0] + a[1] * a[1]) + (a[2] * a[2] + a[3] * a[3]) + (b[0] * b[0] + b[1] * b[1]) + (b[2] * b[2] + b[3] * b[3]);
                }
                ss += __shfl_xor(ss, 16); ss += __shfl_xor(ss, 32); if (fq == 0) part[(wr * 64 + fr + ai * HALF + (mb + m) * 16) * 4 + wc] = ss;
            }
        }
        sq_store(part, sqout, u, wr, wc, fr, fq);
    }
};

template <bool ISK, bool ACCI8 = false> struct EpiQK {
    bf16_t* q; unsigned char* q8; unsigned char* k8; const float* sqin; const float* cs; const float* sn; float* km; const float* wmax; float ascale;
    DI void operator()(Acc& acc, const Unit& u, int wr, int wc, int fr, int fq) const {
        constexpr bool isk = ISK; unsigned char* dst8 = isk ? k8 : q8; const int pnl = u.pn;
        const int row0 = u.pm * BM + wr * 64 + fr, col0 = pnl * BM + wc * 32 + 8 * fq;
        f32x4 csum[2][2];
#pragma unroll
        for (int bj = 0; bj < 2; ++bj)
#pragma unroll
            for (int n = 0; n < 2; ++n) csum[bj][n] = (f32x4){0.f, 0.f, 0.f, 0.f};
        float rvs[2][4];
#pragma unroll
        for (int ai = 0; ai < 2; ++ai)
#pragma unroll
            for (int m = 0; m < 4; ++m) rvs[ai][m] = sq_rstd(sqin, row0 + ai * HALF + m * 16) * ascale;
        if constexpr (ACCI8) {
#pragma unroll
            for (int bj = 0; bj < 2; ++bj)
#pragma unroll
                for (int n = 0; n < 2; ++n) { const f32x4 dq = *(const f32x4*)(wmax + col0 + bj * HALF + 4 * n) * (1.0f / 127.0f);
#pragma unroll
                    for (int ai = 0; ai < 2; ++ai)
#pragma unroll
                        for (int m = 0; m < 4; ++m) acc[ai][bj][m][n] = cvt4i(acc[ai][bj][m][n]) * (dq * rvs[ai][m]); } }
#define QK_ACC(n_) (ACCI8 ? acc[ai][bj][m][n_] : acc[ai][bj][m][n_] * rv)
        if (wc == 0) {
#pragma unroll
            for (int rp = 0; rp < 4; ++rp) {
                const int ai = rp >> 1, mb = 2 * (rp & 1);
                f32x4 c0s[2], c1s[2], s0s[2], s1s[2];
#pragma unroll
                for (int mm = 0; mm < 2; ++mm) { const int pos = (row0 + ai * HALF + (mb + mm) * 16) & (SEQ - 1); const float* cp = cs + pos * 16 + 8 * (fq & 1); const float* sp = sn + pos * 16 + 8 * (fq & 1);
                    c0s[mm] = *(const f32x4*)cp; c1s[mm] = *(const f32x4*)(cp + 4); s0s[mm] = *(const f32x4*)sp; s1s[mm] = *(const f32x4*)(sp + 4); }
#pragma unroll
                for (int mm = 0; mm < 2; ++mm) {
                    const int m = mb + mm; const size_t base = (size_t)(row0 + ai * HALF + m * 16) * D + col0; const float rv = rvs[ai][m];
#pragma unroll
                    for (int bj = 0; bj < 2; ++bj) {
                        f32x4 a = QK_ACC(0), b = QK_ACC(1), pa, pb;
#pragma unroll
                        for (int e = 0; e < 4; ++e) { pa[e] = __shfl_xor(a[e], 32); pb[e] = __shfl_xor(b[e], 32); }
                        if (fq < 2) { a = a * c0s[mm] - pa * s0s[mm]; b = b * c1s[mm] - pb * s1s[mm]; } else { a = a * c0s[mm] + pa * s0s[mm]; b = b * c1s[mm] + pb * s1s[mm]; }
                        if constexpr (!ISK) { u32x4 w; w.x = pk2(a[0], a[1]); w.y = pk2(a[2], a[3]); w.z = pk2(b[0], b[1]); w.w = pk2(b[2], b[3]); *(u32x4*)(q + base + bj * HALF) = w; }
                        *(u32x2*)(dst8 + base + bj * HALF) = (u32x2){pk4_fp8(a[0] * S8_QK, a[1] * S8_QK, a[2] * S8_QK, a[3] * S8_QK), pk4_fp8(b[0] * S8_QK, b[1] * S8_QK, b[2] * S8_QK, b[3] * S8_QK)};
                        if constexpr (ISK) { csum[bj][0] += a; csum[bj][1] += b; }
                    }
                }
            }
        } else {
#pragma unroll
            for (int ai = 0; ai < 2; ++ai)
#pragma unroll
                for (int m = 0; m < 4; ++m) {
                    const size_t base = (size_t)(row0 + ai * HALF + m * 16) * D + col0; const float rv = rvs[ai][m];
#pragma unroll
                    for (int bj = 0; bj < 2; ++bj) {
                        const f32x4 a = QK_ACC(0), b = QK_ACC(1);
                        if constexpr (!ISK) { u32x4 w; w.x = pk2(a[0], a[1]); w.y = pk2(a[2], a[3]); w.z = pk2(b[0], b[1]); w.w = pk2(b[2], b[3]); *(u32x4*)(q + base + bj * HALF) = w; }
                        *(u32x2*)(dst8 + base + bj * HALF) = (u32x2){pk4_fp8(a[0] * S8_QK, a[1] * S8_QK, a[2] * S8_QK, a[3] * S8_QK), pk4_fp8(b[0] * S8_QK, b[1] * S8_QK, b[2] * S8_QK, b[3] * S8_QK)};
                        if constexpr (ISK) { csum[bj][0] += a; csum[bj][1] += b; }
                    }
                }
        }
        if constexpr (ISK) {
            const int bb = u.pm >> 6, blk = u.pm & 63;
#pragma unroll
            for (int bj = 0; bj < 2; ++bj)
#pragma unroll
                for (int n = 0; n < 2; ++n)
#pragma unroll
                    for (int e = 0; e < 4; ++e) {
                        float v = csum[bj][n][e];
                        v += __shfl_xor(v, 1); v += __shfl_xor(v, 2); v += __shfl_xor(v, 4); v += __shfl_xor(v, 8);
                        if (fr == 0) unsafeAtomicAdd(km + (size_t)((bb * NH + pnl * 2 + bj) * NBLK + blk) * HD + wc * 32 + 8 * fq + 4 * n + e, v);
                    }
        }
#undef QK_ACC
    }
};

template <bool ACCI8 = false> struct EpiVT {
    unsigned char* vt; const float* sqin; const float* wmax; float ascale;
    DI void operator()(const Acc& acc, const Unit& u, int wr, int wc, int fr, int fq) const {
        const int row0 = u.pm * BM + wr * 64 + fr, col0 = u.pn * BM + wc * 32 + 8 * fq;
        f32x4 r0[2], r1[2];
#pragma unroll
        for (int bj = 0; bj < 2; ++bj)
#pragma unroll
            for (int e = 0; e < 4; ++e) { r0[bj][e] = sq_rstd(sqin, col0 + bj * HALF + e); r1[bj][e] = sq_rstd(sqin, col0 + bj * HALF + 4 + e); }
#pragma unroll
        for (int ai = 0; ai < 2; ++ai)
#pragma unroll
            for (int m = 0; m < 4; ++m) {
                const int row = row0 + ai * HALF + m * 16;
                const float dqr = ACCI8 ? wmax[row] * (S8_V * ascale / 127.0f) : S8_V * ascale;
#pragma unroll
                for (int bj = 0; bj < 2; ++bj) {
                    const f32x4 a = (ACCI8 ? cvt4i(acc[ai][bj][m][0]) : acc[ai][bj][m][0]) * (r0[bj] * dqr), b = (ACCI8 ? cvt4i(acc[ai][bj][m][1]) : acc[ai][bj][m][1]) * (r1[bj] * dqr);
                    *(u32x2*)(vt + (size_t)row * T + col0 + bj * HALF) = (u32x2){pk4_fp8(a[0], a[1], a[2], a[3]), pk4_fp8(b[0], b[1], b[2], b[3])};
                }
            }
    }
};

struct EpiPP {
    bf16_t* out;
    DI void operator()(const Acc& acc, const Unit& u, int wr, int wc, int fr, int fq) const {
        const int row0 = u.pm * BM + wr * 64 + fr, col0 = u.pn * BM + wc * 32 + 8 * fq;
#pragma unroll
        for (int ai = 0; ai < 2; ++ai)
#pragma unroll
            for (int m = 0; m < 4; ++m) {
                const size_t base = (size_t)(row0 + ai * HALF + m * 16) * D + col0;
#pragma unroll
                for (int bj = 0; bj < 2; ++bj) { const f32x4 a = acc[ai][bj][m][0], b = acc[ai][bj][m][1];
                    u32x4 w; w.x = pk2(a[0], a[1]); w.y = pk2(a[2], a[3]); w.z = pk2(b[0], b[1]); w.w = pk2(b[2], b[3]);
                    *(u32x4*)(out + base + bj * HALF) = w; }
            }
    }
};

struct EpiMoE2 {
    const int* dst; const float* gate; bf16_t* y1; bf16_t* y2; float gs;
    DI void operator()(const Acc& acc, const Unit& u, int wr, int wc, int fr, int fq) const {
        const int s0 = u.pm * BM + wr * 64 + fr, col0 = u.pn * BM + wc * 32 + 8 * fq;
        int ds[2][4]; float gvs[2][4];
#pragma unroll
        for (int ai = 0; ai < 2; ++ai)
#pragma unroll
            for (int m = 0; m < 4; ++m) { const int slot = s0 + ai * HALF + m * 16; ds[ai][m] = dst[slot]; gvs[ai][m] = gate[slot] * gs; }
#pragma unroll
        for (int ai = 0; ai < 2; ++ai)
#pragma unroll
            for (int m = 0; m < 4; ++m) {
                const int d = ds[ai][m]; const float gv = gvs[ai][m];
                if (d >= 0) {
                    bf16_t* yb = ((d & 1) ? y2 : y1) + (size_t)(d >> 1) * D + col0;
#pragma unroll
                    for (int bj = 0; bj < 2; ++bj) { const f32x4 a = acc[ai][bj][m][0] * gv, b = acc[ai][bj][m][1] * gv;
                        u32x4 w; w.x = pk2(a[0], a[1]); w.y = pk2(a[2], a[3]); w.z = pk2(b[0], b[1]); w.w = pk2(b[2], b[3]);
                        *(u32x4*)(yb + bj * HALF) = w; }
                }
            }
    }
};
}

struct Args { const float* in[23]; float* out; unsigned char* ws; int ph_lo, ph_hi; };
struct Frame {
    LAS unsigned char* lds; int G, wv;
    float* out; unsigned char* ws;
};
#define PHASE_IDS int wvv_ = F.wv; asm volatile("" : "+s"(wvv_)); int tid_ = wvv_ * 64 + lane_id(); asm volatile("" : "+v"(tid_)); const int lane_ = tid_ & 63, wave_ = __builtin_amdgcn_readfirstlane(tid_ >> 6); (void)lane_; (void)wave_
DI const float* inp(int i) { const char* ka = (const char*)__builtin_amdgcn_kernarg_segment_ptr(); asm volatile("" : "+s"(ka)); return *(const float* const*)(ka + 8 * i); }
enum { I_X = 0, I_P, I_POOL_NORM, I_POOL_W, I_POOL_SCALE, I_KV_NORM, I_WK, I_WV, I_ATTN_NORM, I_WQ, I_WO, I_FFN_NORM, I_W1, I_W3, I_W2, I_ROUTER, I_EW1, I_EW3, I_EW2,
       I_PLE_NORM, I_PLE_GATE, I_PLE_PROJ, I_FINAL_NORM };

DI void conv_matrix(const Frame& F, const float* src, int Ks, int Ns, bf16_t* dst, int rbase, int mode, const float* gain, const float* cscale, int& rot) {
    PHASE_IDS;
    LAS bf16_t* tile = (LAS bf16_t*)F.lds;
    const int ntk = Ks >> 6, ntn = Ns >> 6, ntiles = ntk * ntn;
    const int ty = tid_ >> 4, tx = tid_ & 15, wn = tid_ >> 3, wk = tid_ & 7;
    int first = (int)blockIdx.x - rot; if (first < 0) first += F.G;
    for (int tl0 = first; tl0 < ntiles; tl0 += 4 * F.G) {
        f32x4 v[4][2];
#pragma unroll
        for (int q = 0; q < 4; ++q) { const int tl = (tl0 + q * F.G < ntiles) ? tl0 + q * F.G : tl0; const int k0 = (tl % ntk) << 6, n0 = (tl / ntk) << 6;
#pragma unroll
            for (int i = 0; i < 2; ++i) v[q][i] = *(const f32x4*)(src + (size_t)(k0 + ty + 32 * i) * Ns + n0 + 4 * tx); }
#pragma unroll
        for (int q = 0; q < 4; ++q) { const int tl = (tl0 + q * F.G < ntiles) ? tl0 + q * F.G : tl0; const int k0 = (tl % ntk) << 6, n0 = (tl / ntk) << 6;
#pragma unroll
            for (int i = 0; i < 2; ++i) { const int k = ty + 32 * i; f32x4 x = v[q][i];
                if (gain) x = x * gain[k0 + k];
                if (cscale) x = x * *(const f32x4*)(cscale + n0 + 4 * tx);
#pragma unroll
                for (int e = 0; e < 4; ++e) tile[q * 4608 + (4 * tx + e) * 72 + k] = (bf16_t)(pk2(x[e], 0.f) & 0xffffu); } }
        __syncthreads();
#pragma unroll
        for (int q = 0; q < 4; ++q) if (tl0 + q * F.G < ntiles) { const int tl = tl0 + q * F.G; const int k0 = (tl % ntk) << 6, n0 = (tl / ntk) << 6;
            const int n = n0 + wn; const int drow = (mode == 0) ? rbase + n : rbase + (n >> 7) * 256 + (mode - 1) * 128 + (n & 127);
            *(u32x4*)(dst + (size_t)drow * Ks + k0 + wk * 8) = *(const LAS u32x4*)(tile + q * 4608 + wn * 72 + wk * 8); }
        __syncthreads();
    }
    rot = (rot + ntiles) % F.G;
}

DI void conv_matrix_fp8(const Frame& F, const float* src, int Ks, int Ns, unsigned char* dst, int rbase, int mode, const float* gain, float scale, int& rot, const float* colmax = nullptr) {
    PHASE_IDS;
    LAS unsigned char* tile = F.lds;
    const int ntk = Ks >> 7, ntn = Ns >> 6, ntiles = ntk * ntn;
    const int ty = tid_ >> 4, tx = tid_ & 15, wn = tid_ >> 3, wk = tid_ & 7;
    int first = (int)blockIdx.x - rot; if (first < 0) first += F.G;
    for (int tl = first; tl < ntiles; tl += 2 * F.G) {
        const int tl2 = tl + F.G; const bool two = tl2 < ntiles;
        const int k0 = (tl % ntk) << 7, n0 = (tl / ntk) << 6, k1 = two ? (tl2 % ntk) << 7 : k0, n1 = two ? (tl2 / ntk) << 6 : n0;
        f32x4 v[4], w[4];
#pragma unroll
        for (int i = 0; i < 4; ++i) { const int k = 4 * ty + i; v[i] = *(const f32x4*)(src + (size_t)(k0 + k) * Ns + n0 + 4 * tx); w[i] = *(const f32x4*)(src + (size_t)(k1 + k) * Ns + n1 + 4 * tx); }
#pragma unroll
        for (int i = 0; i < 4; ++i) { const int k = 4 * ty + i; v[i] = v[i] * (gain ? gain[k0 + k] * scale : scale); w[i] = w[i] * (gain ? gain[k1 + k] * scale : scale); }
        if (colmax) {
            f32x4 c0 = *(const f32x4*)(colmax + n0 + 4 * tx), c1 = *(const f32x4*)(colmax + n1 + 4 * tx);
#pragma unroll
            for (int e = 0; e < 4; ++e) { c0[e] = 127.0f * frcp(fmaxf(c0[e], 1e-30f)); c1[e] = 127.0f * frcp(fmaxf(c1[e], 1e-30f)); }
#pragma unroll
            for (int i = 0; i < 4; ++i) { v[i] = v[i] * c0; w[i] = w[i] * c1; }
#pragma unroll
            for (int e = 0; e < 4; ++e) { *(LAS unsigned*)(tile + (4 * tx + e) * 144 + 4 * ty) = pk4_i8(v[0][e], v[1][e], v[2][e], v[3][e]);
                                          *(LAS unsigned*)(tile + 9216 + (4 * tx + e) * 144 + 4 * ty) = pk4_i8(w[0][e], w[1][e], w[2][e], w[3][e]); }
        } else {
#pragma unroll
        for (int e = 0; e < 4; ++e) { *(LAS unsigned*)(tile + (4 * tx + e) * 144 + 4 * ty) = pk4_fp8(v[0][e], v[1][e], v[2][e], v[3][e]);
                                      *(LAS unsigned*)(tile + 9216 + (4 * tx + e) * 144 + 4 * ty) = pk4_fp8(w[0][e], w[1][e], w[2][e], w[3][e]); }
        }
        __syncthreads();
        { const int n = n0 + wn; const int drow = (mode == 0) ? rbase + n : rbase + (n >> 7) * 256 + (mode - 1) * 128 + (n & 127);
          *(u32x4*)(dst + (size_t)drow * Ks + k0 + wk * 16) = *(const LAS u32x4*)(tile + wn * 144 + wk * 16); }
        if (two) { const int n = n1 + wn; const int drow = (mode == 0) ? rbase + n : rbase + (n >> 7) * 256 + (mode - 1) * 128 + (n & 127);
          *(u32x4*)(dst + (size_t)drow * Ks + k1 + wk * 16) = *(const LAS u32x4*)(tile + 9216 + wn * 144 + wk * 16); }
        __syncthreads();
    }
    rot = (rot + ntiles) % F.G;
}

DI void sincos_acc(float ang, float& c, float& s) {
    const double a = (double)ang;
    const double q = __builtin_rint(a * 0.63661977236758134308);
    double r = __builtin_fma(-q, 1.57079632679489655800e+00, a); r = __builtin_fma(-q, 6.12323399573676603587e-17, r);
    const double r2 = r * r;
    double sp = -7.6471637318198164759e-13; sp = sp * r2 + 1.6059043836821614599e-10; sp = sp * r2 - 2.5052108385441718775e-08; sp = sp * r2 + 2.7557319223985890653e-06;
    sp = sp * r2 - 1.9841269841269841270e-04; sp = sp * r2 + 8.3333333333333333333e-03; sp = sp * r2 - 1.6666666666666666667e-01; const double sr = r + r * r2 * sp;
    double cp = 4.7794773323873852974e-14; cp = cp * r2 - 1.1470745597729724714e-11; cp = cp * r2 + 2.0876756987868098979e-09; cp = cp * r2 - 2.7557319223985890653e-07;
    cp = cp * r2 + 2.4801587301587301587e-05; cp = cp * r2 - 1.3888888888888888889e-03; cp = cp * r2 + 4.1666666666666666667e-02; cp = cp * r2 - 0.5; const double cr = 1.0 + r2 * cp;
    const int qi = (int)((long long)q & 3);
    const double sv = (qi == 0) ? sr : (qi == 1) ? cr : (qi == 2) ? -sr : -cr;
    const double cv = (qi == 0) ? cr : (qi == 1) ? -sr : (qi == 2) ? -cr : sr;
    c = (float)cv; s = (float)sv;
}

DI void colmax_pass(const Frame& F, const float* src, int Ns, const float* gain, unsigned* wmax, int& rot) {
    PHASE_IDS;
    const int njobs = (Ns >> 8) * 32;
    int first = (int)blockIdx.x - rot; if (first < 0) first += F.G;
    for (int job = first; job < njobs; job += F.G) {
        const int cb = job >> 5, rb = job & 31;
        const int n = cb * 256 + (tid_ & 255), r0 = rb * 32 + (tid_ >> 8) * 16;
        float mx = 0.f;
#pragma unroll
        for (int i = 0; i < 16; ++i) mx = fmaxf(mx, fabsf(src[(size_t)(r0 + i) * Ns + n] * gain[r0 + i]));
        atomicMax(wmax + n, __float_as_uint(mx));
    }
    rot = (rot + njobs) % F.G;
}

DI void p0_prologue(const Frame& F) {
    PHASE_IDS;
    unsigned char* ws = F.ws;
    int rot = 0;
    for (int g = 0; g < 4; ++g) conv_matrix(F, inp(I_POOL_W) + (size_t)g * 65536, 256, 256, (bf16_t*)(ws + WO_POOL), g * 256, 0, nullptr, inp(I_POOL_SCALE) + g * 256, rot);
    if (FP8_FFN0 & 1) { conv_matrix_fp8(F, inp(I_W1), D, FF, ws + WO_F13, 0, 1, inp(I_FFN_NORM), S8_W13, rot); conv_matrix_fp8(F, inp(I_W3), D, FF, ws + WO_F13, 0, 2, inp(I_FFN_NORM), S8_W13, rot); }
    else if (I8_UP) {
        colmax_pass(F, inp(I_W1), FF, inp(I_FFN_NORM), (unsigned*)(ws + ZO_WMAX), rot);
        colmax_pass(F, inp(I_W3), FF, inp(I_FFN_NORM), (unsigned*)(ws + ZO_WMAX) + FF, rot);
    }
    else { conv_matrix(F, inp(I_W1), D, FF, (bf16_t*)(ws + WO_F13), 0, 1, inp(I_FFN_NORM), nullptr, rot); conv_matrix(F, inp(I_W3), D, FF, (bf16_t*)(ws + WO_F13), 0, 2, inp(I_FFN_NORM), nullptr, rot); }
    if (FP8_FFN0 & 2) conv_matrix_fp8(F, inp(I_W2), FF, D, ws + WO_F2, 0, 0, nullptr, S8_WF2, rot);
    else conv_matrix(F, inp(I_W2), FF, D, (bf16_t*)(ws + WO_F2), 0, 0, nullptr, nullptr, rot);
    if (I8_PLE & 1) colmax_pass(F, inp(I_PLE_GATE), D, inp(I_PLE_NORM), (unsigned*)(ws + ZO_WMG), rot);
    else conv_matrix(F, inp(I_PLE_GATE), D, D, (bf16_t*)(ws + WO_G0), 0, 0, inp(I_PLE_NORM), nullptr, rot);
    if (I8_PLE & 2) colmax_pass(F, inp(I_PLE_GATE) + (size_t)D * D, D, inp(I_PLE_NORM) + D, (unsigned*)(ws + ZO_WMG) + D, rot);
    else conv_matrix(F, inp(I_PLE_GATE) + (size_t)D * D, D, D, (bf16_t*)(ws + WO_G1), 0, 0, inp(I_PLE_NORM) + D, nullptr, rot);
    conv_matrix(F, inp(I_PLE_PROJ), PD, D, (bf16_t*)(ws + WO_P0), 0, 0, nullptr, nullptr, rot);
    conv_matrix(F, inp(I_PLE_PROJ) + (size_t)PD * D, PD, D, (bf16_t*)(ws + WO_P1), 0, 0, nullptr, nullptr, rot);
    if (I8_QKV) {
        colmax_pass(F, inp(I_WQ), D, inp(I_ATTN_NORM), (unsigned*)(ws + ZO_WMQKV), rot);
        colmax_pass(F, inp(I_WK), D, inp(I_KV_NORM), (unsigned*)(ws + ZO_WMQKV) + D, rot);
        colmax_pass(F, inp(I_WV), D, inp(I_KV_NORM), (unsigned*)(ws + ZO_WMQKV) + 2 * D, rot);
    } else {
    conv_matrix(F, inp(I_WQ), D, D, (bf16_t*)(ws + WO_QK), 0, 0, inp(I_ATTN_NORM), nullptr, rot);
    conv_matrix(F, inp(I_WK), D, D, (bf16_t*)(ws + WO_QK), D, 0, inp(I_KV_NORM), nullptr, rot);
    conv_matrix_fp8(F, inp(I_WV), D, D, ws + WO_V, 0, 0, inp(I_KV_NORM), S8_WKV, rot);
    }
    conv_matrix(F, inp(I_WO), D, D, (bf16_t*)(ws + WO_O), 0, 0, nullptr, nullptr, rot);
    {
        const float* p = inp(I_P); bf16_t* pb = (bf16_t*)(ws + WS_PB);
        const size_t n8 = (size_t)2 * T * PD / 8;
        for (size_t i = (size_t)blockIdx.x * 512 + tid_; i < n8; i += (size_t)F.G * 512) {
            const f32x4 a = *(const f32x4*)(p + i * 8), b = *(const f32x4*)(p + i * 8 + 4);
            u32x4 w; w.x = pk2(a[0], a[1]); w.y = pk2(a[2], a[3]); w.z = pk2(b[0], b[1]); w.w = pk2(b[2], b[3]);
            *(u32x4*)(pb + i * 8) = w;
        }
    }
    {
        float* cs = (float*)(ws + WS_ROPE); float* sn = cs + SEQ * 16;
        for (int i = blockIdx.x * 512 + tid_; i < SEQ * 16; i += F.G * 512) {
            const int pos = i >> 4, f = i & 15;
            const float inv = __uint_as_float(f == 0 ? 0x3f800000u : 0u) + ((f == 1) ? 4.403665960e-01f : (f == 2) ? 1.939227432e-01f : (f == 3) ? 8.539710194e-02f : (f == 4) ? 3.760603070e-02f :
                (f == 5) ? 1.656044088e-02f : (f == 6) ? 7.292664610e-03f : (f == 7) ? 3.211446106e-03f : (f == 8) ? 1.414213562e-03f : (f == 9) ? 6.227724371e-04f : (f == 10) ? 2.742481884e-04f :
                (f == 11) ? 1.207697351e-04f : (f == 12) ? 5.318295734e-05f : (f == 13) ? 2.341999971e-05f : (f == 14) ? 1.031338525e-05f : (f == 15) ? 4.541670478e-06f : 0.f);
            const float ang = (float)pos * inv;
            float c, s; sincos_acc(ang, c, s); cs[i] = c; sn[i] = s;
        }
    }
    {
        LAS float* rsl = (LAS float*)(F.lds + 65536);
        const float* x = inp(I_X); const float* pg = inp(I_POOL_NORM);
        bf16_t* pooled = (bf16_t*)(ws + O_POOLED);
        for (int tile = blockIdx.x; tile < T / 128; tile += F.G) {
            const int s0 = tile * 128, p0 = s0 & (SEQ - 1), halo = p0 < 15 ? p0 : 15;
            for (int r0 = wave_; r0 < halo + 128; r0 += 32) {
                f32x4 v[4][4];
#pragma unroll
                for (int q = 0; q < 4; ++q) { const int r = r0 + 8 * q; const int rc = r < halo + 128 ? r : halo + 127;
                    const float* xp = x + (size_t)(s0 - halo + rc) * D + lane_ * 4;
#pragma unroll
                    for (int j = 0; j < 4; ++j) v[q][j] = *(const f32x4*)(xp + j * 256); }
                float ss[4];
#pragma unroll
                for (int q = 0; q < 4; ++q) { float a = 0.f;
#pragma unroll
                    for (int j = 0; j < 4; ++j) a += (v[q][j][0] * v[q][j][0] + v[q][j][1] * v[q][j][1]) + (v[q][j][2] * v[q][j][2] + v[q][j][3] * v[q][j][3]);
                    ss[q] = a; }
#pragma unroll
                for (int q = 0; q < 4; ++q) ss[q] = wave_sum(ss[q]);
#pragma unroll
                for (int q = 0; q < 4; ++q) { const int r = r0 + 8 * q; if (lane_ == 0 && r < halo + 128) rsl[15 - halo + r] = __builtin_amdgcn_rsqf(ss[q] * (1.0f / D) + EPS); }
            }
            __syncthreads();
            {
                const int g = wave_ & 3, half = wave_ >> 2, W = 2 << g;
                const int cb = g * 256 + lane_ * 4;
                const f32x4 gn = *(const f32x4*)(pg + cb);
                const int ss0 = s0 + half * 64, ps0 = p0 + half * 64;
                const float* xc = x + cb;
                f32x4 sum = (f32x4){0.f, 0.f, 0.f, 0.f};
                for (int i = 1; i < W; ++i) if (ps0 - i >= 0) sum += *(const f32x4*)(xc + (size_t)(ss0 - i) * D) * (rsl[ss0 - i - s0 + 15] * gn);
                bf16_t* op = pooled + ((size_t)g * T + ss0) * 256 + lane_ * 4;
#pragma unroll 1
                for (int c8 = 0; c8 < 8; ++c8) {
                    f32x4 cur[8], old[8];
#pragma unroll
                    for (int i = 0; i < 8; ++i) { const int r = c8 * 8 + i, s = ss0 + r, pos = ps0 + r;
                        cur[i] = *(const f32x4*)(xc + (size_t)s * D);
                        const int so = (pos - W + 1 >= 0) ? s - W + 1 : s;
                        old[i] = *(const f32x4*)(xc + (size_t)so * D); }
#pragma unroll
                    for (int i = 0; i < 8; ++i) { const int r = c8 * 8 + i, s = ss0 + r, pos = ps0 + r;
                        const f32x4 cv = cur[i] * (rsl[s - s0 + 15] * gn);
                        sum += cv;
                        const int cnt = (pos + 1 < W) ? pos + 1 : W;
                        const f32x4 o = sum * frcp((float)cnt) - cv;
                        u32x2 w; w.x = pk2(o[0], o[1]); w.y = pk2(o[2], o[3]);
                        *(u32x2*)(op + (size_t)r * 256) = w;
                        if (pos - W + 1 >= 0) sum -= old[i] * (rsl[s - W + 1 - s0 + 15] * gn); }
                }
            }
            __syncthreads();
        }
    }
}

DI void conv_moe_weights(const Frame& F) {
    unsigned char* ws = F.ws; int rot = 0;
    for (int e = 0; e < NE; ++e) {
        conv_matrix_fp8(F, inp(I_EW1) + (size_t)e * D * EFF, D, EFF, ws + O_WE13, e * 2 * EFF, 1, inp(I_FFN_NORM) + D, S8_W13, rot);
        conv_matrix_fp8(F, inp(I_EW3) + (size_t)e * D * EFF, D, EFF, ws + O_WE13, e * 2 * EFF, 2, inp(I_FFN_NORM) + D, S8_W13, rot);
        conv_matrix_fp8(F, inp(I_EW2) + (size_t)e * EFF * D, EFF, D, ws + O_WE2, e * D, 0, nullptr, S8_W2, rot);
    }
}

DI bool sel_better(float v, int i, float w, int k) { return (v > w) || (v == w && i < k); }
DI void sel_insert(float v, int i, float& v0, int& i0, float& v1, int& i1, float& v2, int& i2) {
    const bool b0 = sel_better(v, i, v0, i0), b1 = sel_better(v, i, v1, i1), b2 = sel_better(v, i, v2, i2);
    const float n2 = b1 ? v1 : (b2 ? v : v2), n1 = b0 ? v0 : (b1 ? v : v1), n0 = b0 ? v : v0;
    const int m2 = b1 ? i1 : (b2 ? i : i2), m1 = b0 ? i0 : (b1 ? i : i1), m0 = b0 ? i : i0;
    v0 = n0; v1 = n1; v2 = n2; i0 = m0; i1 = m1; i2 = m2;
}
DI void moba_select(const Frame& F) {
    PHASE_IDS;
    unsigned char* ws = F.ws;
    const bf16_t* Q = (const bf16_t*)(ws + O_Q); const float* KM = (const float*)(ws + ZO_KM);
    unsigned* LCNT = (unsigned*)(ws + ZO_LCNT); unsigned short* LIST = (unsigned short*)(ws + O_LIST);
    LAS bf16_t* kh = (LAS bf16_t*)F.lds;
    LAS bf16_t* kl = kh + 64 * 136;
    LAS unsigned* lcnt = (LAS unsigned*)(F.lds + 49152); LAS unsigned* lbase = lcnt + 64;
    const int fr = lane_ & 15, fq = lane_ >> 4;
    for (int unit = blockIdx.x; unit < BATCH * NH * 32; unit += F.G) {
        const int b = unit >> 8, h = (unit >> 5) & 7, c = b ? 31 - (unit & 31) : (unit & 31);
        const int jmax = 2 * c + 1;
        for (int idx = tid_; idx < 64 * 32; idx += 512) {
            const int n = idx >> 5, d4 = idx & 31;
            f32x4 v = (f32x4){0.f, 0.f, 0.f, 0.f};
            if (n < jmax) v = *(const f32x4*)(KM + (size_t)((b * NH + h) * NBLK + n) * HD + d4 * 4) * (1.0f / 256.0f);
            unsigned hi[4], lo[4];
#pragma unroll
            for (int e = 0; e < 4; ++e) { hi[e] = pk2(v[e], 0.f) & 0xffffu; lo[e] = pk2(v[e] - __uint_as_float(hi[e] << 16), 0.f) & 0xffffu; }
            *(LAS u32x2*)(kh + n * 136 + d4 * 4) = (u32x2){hi[0] | (hi[1] << 16), hi[2] | (hi[3] << 16)};
            *(LAS u32x2*)(kl + n * 136 + d4 * 4) = (u32x2){lo[0] | (lo[1] << 16), lo[2] | (lo[3] << 16)};
        }
        if (tid_ < 64) lcnt[tid_] = 0u;
        __syncthreads();
        int selv[4]; unsigned lpv[4];
#pragma unroll
        for (int gi = 0; gi < 4; ++gi) {
            const int s = c * 512 + (wave_ * 4 + gi) * 16 + fr;
            const int j = (c * 512 + (wave_ * 4 + gi) * 16) >> 8;
            const bf16_t* qp = Q + ((size_t)(b * SEQ + s)) * D + h * HD + 8 * fq;
            bf16x8 qf[4];
#pragma unroll
            for (int ks = 0; ks < 4; ++ks) qf[ks] = *(const bf16x8*)(qp + 32 * ks);
            f32x4 acc[4];
#pragma unroll
            for (int nt = 0; nt < 4; ++nt) { acc[nt] = (f32x4){0.f, 0.f, 0.f, 0.f};
#pragma unroll
                for (int ks = 0; ks < 4; ++ks) {
                    const bf16x8 ah = *(const LAS bf16x8*)(kh + (16 * nt + fr) * 136 + 32 * ks + 8 * fq), al = *(const LAS bf16x8*)(kl + (16 * nt + fr) * 136 + 32 * ks + 8 * fq);
                    acc[nt] = __builtin_amdgcn_mfma_f32_16x16x32_bf16(ah, qf[ks], acc[nt], 0, 0, 0);
                    acc[nt] = __builtin_amdgcn_mfma_f32_16x16x32_bf16(al, qf[ks], acc[nt], 0, 0, 0);
                } }
            float v0 = -3.0e38f, v1 = -3.0e38f, v2 = -3.0e38f; int i0 = 1000, i1 = 1001, i2 = 1002;
#pragma unroll
            for (int nt = 0; nt < 4; ++nt)
#pragma unroll
                for (int e = 0; e < 4; ++e) { const int n = 16 * nt + 4 * fq + e; if (n < j) sel_insert(acc[nt][e], n, v0, i0, v1, i1, v2, i2); }
#pragma unroll
            for (int sti = 0; sti < 2; ++sti) { const int st = 16 << sti;
                const float w0 = __shfl_xor(v0, st), w1 = __shfl_xor(v1, st), w2 = __shfl_xor(v2, st);
                const int k0 = __shfl_xor(i0, st), k1 = __shfl_xor(i1, st), k2 = __shfl_xor(i2, st);
                sel_insert(w0, k0, v0, i0, v1, i1, v2, i2); sel_insert(w1, k1, v0, i0, v1, i1, v2, i2); sel_insert(w2, k2, v0, i0, v1, i1, v2, i2);
            }
            const int nsel = j < 3 ? j : 3;
            const int mine = (fq == 0) ? i0 : (fq == 1) ? i1 : i2;
            selv[gi] = (fq < nsel) ? mine : -1; lpv[gi] = 0u;
            if (selv[gi] >= 0) lpv[gi] = lds_add(lcnt + selv[gi], 1u);
        }
        __syncthreads();
        if (tid_ < 64) { const unsigned cc = lcnt[tid_]; lbase[tid_] = cc ? atomicAdd(LCNT + (b * NH + h) * NBLK + tid_, cc) : 0u; }
        __syncthreads();
        { unsigned short* lb = LIST + (size_t)((b * NH + h) * NBLK) * SEQ;
#pragma unroll
          for (int gi = 0; gi < 4; ++gi) if (selv[gi] >= 0) { const int s = c * 512 + (wave_ * 4 + gi) * 16 + fr;
              lb[(size_t)selv[gi] * SEQ + lbase[selv[gi]] + lpv[gi]] = (unsigned short)((s << 2) | fq); } }
        __syncthreads();
    }
}

#define MFMA32(a, b, c) __builtin_amdgcn_mfma_f32_32x32x16_bf16((a), (b), (c), 0, 0, 0)
DI bf16x8 pack8(const f32x16& x, int s) {
    u32x4 p; p.x = pk2(x[8 * s], x[8 * s + 1]); p.y = pk2(x[8 * s + 2], x[8 * s + 3]); p.z = pk2(x[8 * s + 4], x[8 * s + 5]); p.w = pk2(x[8 * s + 6], x[8 * s + 7]);
    return __builtin_bit_cast(bf16x8, p);
}
DI void moba_partial(const Frame& F) {
    unsigned char* ws = F.ws;
    const unsigned char* Q8 = ws + O_Q8; const unsigned char* K8 = ws + O_K8; const unsigned char* VT8 = ws + O_VT8;
    const unsigned* LCNT = (const unsigned*)(ws + ZO_LCNT); const unsigned short* LIST0 = (const unsigned short*)(ws + O_LIST);
    unsigned char* PO = ws + O_PO; f32x2* ML = (f32x2*)(ws + O_ML);
    unsigned* qctr = (unsigned*)(ws + ZO_CNT) + 128;
    LAS int* pre = (LAS int*)(F.lds + TAB_OFF);
    LAS int* qslot = (LAS int*)(F.lds + MISC_OFF + 64);
    int wvv = F.wv; asm volatile("" : "+s"(wvv)); int tid = wvv * 64 + lane_id(); asm volatile("" : "+v"(tid));
    const int w = F.wv;
    int cur = 0;
#pragma unroll
    for (int q = 0; q < 2; ++q) { const int io = tid + 512 * q, bh = io & 15, nq = io >> 4; const int cnt = (int)LCNT[bh * NBLK + nq]; const int tiles = 1 + ((cnt + 255) >> 8); pre[io] = (tiles + ATT_C - 1) / ATT_C; }
    __syncthreads();
    for (int off = 1; off < 1024; off <<= 1) {
        int v[2];
#pragma unroll
        for (int q = 0; q < 2; ++q) { const int io = tid + 512 * q; v[q] = pre[cur * 1024 + io] + (io >= off ? pre[cur * 1024 + io - off] : 0); }
#pragma unroll
        for (int q = 0; q < 2; ++q) pre[(cur ^ 1) * 1024 + tid + 512 * q] = v[q];
        __syncthreads(); cur ^= 1; }
    const LAS int* pf = pre + cur * 1024;
    const int U = __builtin_amdgcn_readfirstlane(pf[1023]);
    for (;;) {
        if (tid == 0) *qslot = (int)__hip_atomic_fetch_add(qctr, 1u, __ATOMIC_RELAXED, __HIP_MEMORY_SCOPE_AGENT);
        __syncthreads();
        const int u = __builtin_amdgcn_readfirstlane(*qslot);
        if (u >= U) break;
        int lo = 0, hi = 1023;
        while (lo < hi) { const int mid = (lo + hi) >> 1; if (pf[mid] > u) hi = mid; else lo = mid + 1; }
        const int io = lo, chunk = u - (io ? pf[io - 1] : 0);
        const int h = io & 7, b = (io >> 3) & 1, n = io >> 4, item = (b * NH + h) * NBLK + n;
        const unsigned short* LIST = LIST0;
        const int cnt = (int)LCNT[item];
        const int ntile = 1 + ((cnt + 255) >> 8);
        const int tile0 = chunk * ATT_C, tile1 = (tile0 + ATT_C < ntile) ? tile0 + ATT_C : ntile;
        const size_t tbase = (size_t)b * SEQ + n * 256;
        asm volatile("" : "+v"(tid));
        const int lane = tid & 63, r = lane & 31, hh = lane >> 5;
        const int qi = 32 * w + r;
#pragma unroll
        for (int i = 0; i < 4; ++i) { const int p = tid + 512 * i, key = p >> 3, c = p & 7;
            const u32x4 v = *(const u32x4*)(K8 + (tbase + key) * D + h * HD + c * 16);
            *(LAS u32x4*)(F.lds + key * 128 + ((c ^ ((key >> 1) & 7)) << 4)) = v; }
#pragma unroll
        for (int i = 0; i < 4; ++i) { const int p = tid + 512 * i, d = p >> 4, j16 = p & 15, G = j16 >> 2, j = j16 & 3;
            const u32x4 v = *(const u32x4*)(VT8 + (size_t)(h * HD + d) * T + tbase + j16 * 16);
            const int pos0 = (j >> 1) * 16 + (j & 1) * 8;
            const int bo0 = G * 64 + pos0, bo1 = bo0 + 32;
            *(LAS u32x2*)(F.lds + 32768 + d * 256 + ((((bo0 >> 4) ^ (d & 15)) << 4) | (bo0 & 15))) = (u32x2){v.x, v.z};
            *(LAS u32x2*)(F.lds + 32768 + d * 256 + ((((bo1 >> 4) ^ (d & 15)) << 4) | (bo1 & 15))) = (u32x2){v.y, v.w}; }
        __syncthreads();
#define MFMA8Z(acc_, a_, b_) asm volatile("v_mfma_scale_f32_32x32x64_f8f6f4 %0, %1, %2, 0, %3, %3 op_sel_hi:[0,0,0]" : "=&v"(acc_) : "v"(a_), "v"(b_), "v"(one_e8m0))
#define MFMA8(acc_, a_, b_) asm volatile("v_mfma_scale_f32_32x32x64_f8f6f4 %0, %1, %2, %0, %3, %3 op_sel_hi:[0,0,0]" : "+v"(acc_) : "v"(a_), "v"(b_), "v"(one_e8m0))
#define MFMA_SETTLE() asm volatile("s_nop 7\n\ts_nop 7\n\ts_nop 7" ::: "memory")
        const int one_e8m0 = 0x7F7F7F7F;
#pragma unroll 1
        for (int tile = tile0; tile < tile1; ++tile) {
        bool valid; int sl, rr;
        if (tile == 0) { sl = n * 256 + qi; rr = 3; valid = true; }
        else { const int idx = (tile - 1) * 256 + qi; valid = idx < cnt; const int e = valid ? (int)LIST[(size_t)item * SEQ + idx] : 0; sl = e >> 2; rr = e & 3; }
        (void)rr; (void)valid;
        const bool wave_active = (tile == 0) || ((tile - 1) * 256 + 32 * w < cnt);
        if (wave_active) {
            i32x8 qf[2];
            { const unsigned char* qp = Q8 + ((size_t)b * SEQ + sl) * D + h * HD + 32 * hh;
#pragma unroll
              for (int mf = 0; mf < 2; ++mf) qf[mf] = __builtin_shufflevector(*(const i32x4*)(qp + 64 * mf), *(const i32x4*)(qp + 64 * mf + 16), 0, 1, 2, 3, 4, 5, 6, 7); }
            f32x16 o[4];
            float mrun = -__builtin_inff(), lrun = 0.f;
            const float sc = 0.08838834764831845f * 1.4426950408889634f * (1.0f / (S8_QK * S8_QK));
            const int nhalf = (tile == 0 && w < 4) ? 1 : 2;
            const int rq0 = (r >> 3) & 3, rl0 = r & 7;
#pragma unroll 1
            for (int hf = 0; hf < nhalf; ++hf) {
                int rl = rl0, rq = rq0; asm volatile("" : "+v"(rl), "+v"(rq));
                const int rr_ = (rq << 3) | rl;
                f32x16 x[4];
                {
                    const int ksw = (rr_ >> 1) & 7;
                    const LAS unsigned char* kl = F.lds + hf * 16384 + rr_ * 128;
#pragma unroll
                    for (int mf = 0; mf < 2; ++mf)
#pragma unroll
                        for (int kt = 0; kt < 4; ++kt) {
                            const i32x4 k0 = *(const LAS i32x4*)(kl + kt * 4096 + (((4 * mf + 2 * hh) ^ ksw) << 4)), k1 = *(const LAS i32x4*)(kl + kt * 4096 + (((4 * mf + 2 * hh + 1) ^ ksw) << 4));
                            const i32x8 kf = __builtin_shufflevector(k0, k1, 0, 1, 2, 3, 4, 5, 6, 7);
                            if (mf == 0) MFMA8Z(x[kt], kf, qf[0]); else MFMA8(x[kt], kf, qf[1]);
                        }
                    MFMA_SETTLE();
                }
                __builtin_amdgcn_sched_barrier(0);
                float mx = mrun;
#pragma unroll
                for (int kt = 0; kt < 4; ++kt)
#pragma unroll
                    for (int i = 0; i < 16; ++i) { float v = x[kt][i];
                        if (tile == 0) { const int key = 128 * hf + 32 * kt + (i & 3) + 8 * (i >> 2) + 4 * hh; if (key > 32 * w + rr_) v = -__builtin_inff(); x[kt][i] = v; }
                        mx = fmaxf(mx, v); }
                mx = fmaxf(mx, __shfl_xor(mx, 32));
                const float mxs = mx * sc;
                const float resc = (hf > 0) ? fexp2((mrun - mx) * sc) : 0.f;
                lrun *= resc;
                if (hf > 0) {
#pragma unroll
                    for (int dt = 0; dt < 4; ++dt)
#pragma unroll
                        for (int i = 0; i < 16; ++i) o[dt][i] *= resc;
                }
                mrun = mx;
                float l = 0.f;
                const LAS unsigned char* vl = F.lds + 32768 + rr_ * 256;
#pragma unroll
                for (int kp = 0; kp < 2; ++kp) {
                    float pv[32];
#pragma unroll
                    for (int a2 = 0; a2 < 2; ++a2)
#pragma unroll
                        for (int i = 0; i < 16; ++i) { const float p = fexp2(__builtin_fmaf(x[2 * kp + a2][i], sc, -mxs)); l += p; pv[a2 * 16 + i] = p * S8_P; }
                    i32x8 pf;
#pragma unroll
                    for (int q4 = 0; q4 < 8; ++q4) { int wv = 0; wv = __builtin_amdgcn_cvt_pk_fp8_f32(pv[4 * q4], pv[4 * q4 + 1], wv, false); wv = __builtin_amdgcn_cvt_pk_fp8_f32(pv[4 * q4 + 2], pv[4 * q4 + 3], wv, true); pf[q4] = wv; }
                    asm volatile("s_nop 3" ::: "memory");
                    const int c0 = 4 * (2 * hf + kp) + 2 * hh;
#pragma unroll
                    for (int dt = 0; dt < 4; ++dt) {
                        const i32x4 v0 = *(const LAS i32x4*)(vl + dt * 8192 + ((c0 ^ (rr_ & 15)) << 4)), v1 = *(const LAS i32x4*)(vl + dt * 8192 + (((c0 + 1) ^ (rr_ & 15)) << 4));
                        const i32x8 vf = __builtin_shufflevector(v0, v1, 0, 1, 2, 3, 4, 5, 6, 7);
                        if (hf == 0 && kp == 0) MFMA8Z(o[dt], vf, pf); else MFMA8(o[dt], vf, pf);
                    }
                    __builtin_amdgcn_sched_barrier(0);
                }
                MFMA_SETTLE();
                l += __shfl_xor(l, 32);
                lrun += l;
                __builtin_amdgcn_sched_barrier(0);
            }
            bool valid2; int sl2, rr2;
            int tl2 = tid; asm volatile("" : "+v"(tl2)); const int ln2 = tl2 & 31, hh2 = (tl2 >> 5) & 1, qi2 = 32 * w + ln2;
            if (tile == 0) { sl2 = n * 256 + qi2; rr2 = 3; valid2 = true; }
            else { const int idx = (tile - 1) * 256 + qi2; valid2 = idx < cnt; const int e = valid2 ? (int)LIST[(size_t)item * SEQ + idx] : 0; sl2 = e >> 2; rr2 = e & 3; }
            if (valid2) {
                const float inv = frcp(lrun);
                const size_t pair = ((size_t)(b * SEQ + sl2) * NH + h) * 4 + rr2;
                unsigned char* po = PO + pair * HD;
                const float is8 = inv * (S8_PO / (S8_V * S8_P));
#pragma unroll
                for (int dt = 0; dt < 4; ++dt)
#pragma unroll
                    for (int g4 = 0; g4 < 4; ++g4)
                        *(unsigned*)(po + 32 * dt + 8 * g4 + 4 * hh2) = pk4_fp8(o[dt][4 * g4] * is8, o[dt][4 * g4 + 1] * is8, o[dt][4 * g4 + 2] * is8, o[dt][4 * g4 + 3] * is8);
                if (hh2 == 0) ML[pair] = (f32x2){mrun * sc, lrun};
            }
        }
        }
#undef MFMA8Z
#undef MFMA8
#undef MFMA_SETTLE
        __syncthreads();
    }
}

DI void moba_combine(const Frame& F) {
    PHASE_IDS;
    unsigned char* ws = F.ws;
    const unsigned char* PO = ws + O_PO; const f32x2* ML = (const f32x2*)(ws + O_ML);
    bf16_t* AO = (bf16_t*)(ws + O_Q);
    for (int it = blockIdx.x * 512 + tid_; it < T * 64; it += F.G * 512) {
        const int t = it >> 6, h = (it >> 3) & 7, dp = it & 7, sq = t & (SEQ - 1);
        const int nv = (sq >> 8) < 3 ? (sq >> 8) : 3;
        const size_t base = ((size_t)t * NH + h) * 4;
        f32x2 ml[4]; float ms = -3.0e38f;
#pragma unroll
        for (int r = 0; r < 4; ++r) { const bool ok = (r == 3) || (r < nv); ml[r] = ok ? ML[base + r] : (f32x2){-3.0e38f, 0.f}; ms = fmaxf(ms, ml[r][0]); }
        float wsum = 0.f; float wr[4];
#pragma unroll
        for (int r = 0; r < 4; ++r) { const bool ok = (r == 3) || (r < nv); wr[r] = ok ? ml[r][1] * fexp2(ml[r][0] - ms) : 0.f; wsum += wr[r]; }
        float acc[16];
#pragma unroll
        for (int i = 0; i < 16; ++i) acc[i] = 0.f;
#pragma unroll
        for (int r = 0; r < 4; ++r) {
            const bool ok = (r == 3) || (r < nv);
            if (ok) {
                const u32x4 a = *(const u32x4*)(PO + (base + r) * HD + dp * 16);
                const float wv = wr[r];
                const unsigned wd[4] = {a.x, a.y, a.z, a.w};
#pragma unroll
                for (int q = 0; q < 4; ++q) { const f32x2 lo2 = __builtin_amdgcn_cvt_pk_f32_fp8((int)wd[q], false), hi2 = __builtin_amdgcn_cvt_pk_f32_fp8((int)wd[q], true);
                    acc[4 * q] += wv * lo2.x; acc[4 * q + 1] += wv * lo2.y; acc[4 * q + 2] += wv * hi2.x; acc[4 * q + 3] += wv * hi2.y; }
            }
        }
        const float inv = frcp(wsum) * (1.0f / S8_PO);
        u32x4 o0, o1;
        o0.x = pk2(acc[0] * inv, acc[1] * inv); o0.y = pk2(acc[2] * inv, acc[3] * inv); o0.z = pk2(acc[4] * inv, acc[5] * inv); o0.w = pk2(acc[6] * inv, acc[7] * inv);
        o1.x = pk2(acc[8] * inv, acc[9] * inv); o1.y = pk2(acc[10] * inv, acc[11] * inv); o1.z = pk2(acc[12] * inv, acc[13] * inv); o1.w = pk2(acc[14] * inv, acc[15] * inv);
        bf16_t* op = AO + (size_t)t * D + h * HD + dp * 16;
        *(u32x4*)op = o0; *(u32x4*)(op + 8) = o1;
    }
}

#if SELFCHECK
DI void sc_sample(int i, int& b, int& sq, int& h) {
    const int special[12] = {0, 1, 255, 256, 257, 511, 512, 767, 768, 1023, 16383, 8191};
    b = i & 1; h = (i >> 1) & 7; const int k = i >> 4;
    sq = (k < 12) ? special[k] : (int)(((unsigned)(k * 7919 + i * 104729 + 12345)) % SEQ);
}
DI void attn_selfcheck_ref(const Frame& F) {
    PHASE_IDS;
    unsigned char* ws = F.ws;
    const bf16_t* Q = (const bf16_t*)(ws + O_Q); const unsigned char* Q8 = ws + O_Q8; const unsigned char* K8 = ws + O_K8; const unsigned char* VT8 = ws + O_VT8; const float* KM = (const float*)(ws + ZO_KM);
#define F8DEC(byte_) __builtin_amdgcn_cvt_f32_fp8((int)(unsigned)(byte_), 0)
    float* ref = (float*)(ws + WS_TOP);
    LAS float* ql = (LAS float*)F.lds; LAS float* gl = ql + 128; LAS float* pl = gl + 64; LAS float* red = pl + 1024; LAS int* sel = (LAS int*)(red + 16); LAS float* part = red + 32; LAS float* q8l = part + 512;
    for (int smp = blockIdx.x; smp < 512; smp += F.G) {
        int b, sq, h; sc_sample(smp, b, sq, h);
        const int j = sq >> 8;
        if (tid_ < 128) { const unsigned short v = Q[((size_t)(b * SEQ + sq)) * D + h * HD + tid_]; ql[tid_] = __uint_as_float((unsigned)v << 16); q8l[tid_] = F8DEC(Q8[((size_t)(b * SEQ + sq)) * D + h * HD + tid_]); }
        __syncthreads();
        if (tid_ < 64) { float g = -3.0e38f;
            if (tid_ < j) { float d0 = 0.f, d1 = 0.f, d2 = 0.f, d3 = 0.f; const float* kp = KM + (size_t)((b * NH + h) * NBLK + tid_) * HD;
                for (int d4 = 0; d4 < 32; ++d4) { d0 += ql[d4 * 4] * (kp[d4 * 4] * (1.0f / 256.0f)); d1 += ql[d4 * 4 + 1] * (kp[d4 * 4 + 1] * (1.0f / 256.0f)); d2 += ql[d4 * 4 + 2] * (kp[d4 * 4 + 2] * (1.0f / 256.0f)); d3 += ql[d4 * 4 + 3] * (kp[d4 * 4 + 3] * (1.0f / 256.0f)); }
                g = (d0 + d1) + (d2 + d3); }
            gl[tid_] = g; }
        __syncthreads();
        if (tid_ == 0) { float v0 = -3.0e38f, v1 = -3.0e38f, v2 = -3.0e38f; int i0 = 0, i1 = 0, i2 = 0;
            for (int n = 0; n < j; ++n) { const float g = gl[n];
                if (g > v0) { v2 = v1; i2 = i1; v1 = v0; i1 = i0; v0 = g; i0 = n; } else if (g > v1) { v2 = v1; i2 = i1; v1 = g; i1 = n; } else if (g > v2) { v2 = g; i2 = n; } }
            const int ns = j < 3 ? j : 3; sel[0] = ns > 0 ? i0 : -1; sel[1] = ns > 1 ? i1 : -1; sel[2] = ns > 2 ? i2 : -1; sel[3] = j; }
        __syncthreads();
        float mloc = -3.0e38f;
        for (int slot = tid_; slot < 1024; slot += 512) { const int bi = slot >> 8, key = slot & 255, blk = sel[bi]; float sc = -3.0e38f;
            if (blk >= 0 && (bi < 3 || blk * 256 + key <= sq)) { const unsigned char* kp = K8 + ((size_t)(b * SEQ + blk * 256 + key)) * D + h * HD; float a = 0.f;
                for (int d = 0; d < HD; ++d) a += q8l[d] * F8DEC(kp[d]);
                sc = a * (0.08838834764831845f / (S8_QK * S8_QK)); }
            pl[slot] = sc; mloc = fmaxf(mloc, sc); }
        mloc = fmaxf(mloc, __shfl_xor(mloc, 32)); mloc = fmaxf(mloc, __shfl_xor(mloc, 16)); mloc = fmaxf(mloc, __shfl_xor(mloc, 8)); mloc = fmaxf(mloc, __shfl_xor(mloc, 4)); mloc = fmaxf(mloc, __shfl_xor(mloc, 2)); mloc = fmaxf(mloc, __shfl_xor(mloc, 1));
        if (lane_ == 0) red[wave_] = mloc;
        __syncthreads();
        float mx = red[0]; for (int w = 1; w < 8; ++w) mx = fmaxf(mx, red[w]);
        __syncthreads();
        float sloc = 0.f;
        for (int slot = tid_; slot < 1024; slot += 512) { const float sc = pl[slot]; const float p = (sc > -1.0e38f) ? fexp2((sc - mx) * 1.4426950408889634f) : 0.f; pl[slot] = p; sloc += p; }
        sloc = wave_sum(sloc);
        if (lane_ == 0) red[wave_] = sloc;
        __syncthreads();
        float ssum = 0.f; for (int w = 0; w < 8; ++w) ssum += red[w];
        { const int d = tid_ & 127, bi = tid_ >> 7, blk = sel[bi]; float a = 0.f;
          if (blk >= 0) { const unsigned char* vp = VT8 + (size_t)(h * HD + d) * T + (size_t)b * SEQ + blk * 256;
              for (int key = 0; key < 256; ++key) a += pl[bi * 256 + key] * (F8DEC(vp[key]) * (1.0f / S8_V)); }
          part[tid_] = a; }
        __syncthreads();
        if (tid_ < 128) ref[(size_t)smp * 128 + tid_] = ((part[tid_] + part[128 + tid_]) + (part[256 + tid_] + part[384 + tid_])) / ssum;
        __syncthreads();
    }
#undef F8DEC
}
DI void attn_selfcheck_cmp(const Frame& F) {
    PHASE_IDS;
    unsigned char* ws = F.ws;
    const bf16_t* AO = (const bf16_t*)(ws + O_Q); const float* ref = (const float*)(ws + WS_TOP); unsigned* flag = (unsigned*)(ws + ZO_CNT) + 320;
    LAS float* red = (LAS float*)F.lds;
    for (int smp = blockIdx.x; smp < 512; smp += F.G) {
        int b, sq, h; sc_sample(smp, b, sq, h);
        float r = 0.f, a = 0.f;
        if (tid_ < 128) { r = ref[(size_t)smp * 128 + tid_]; a = __uint_as_float((unsigned)AO[((size_t)(b * SEQ + sq)) * D + h * HD + tid_] << 16); }
        float mr = fabsf(r); mr = fmaxf(mr, __shfl_xor(mr, 32)); mr = fmaxf(mr, __shfl_xor(mr, 16)); mr = fmaxf(mr, __shfl_xor(mr, 8)); mr = fmaxf(mr, __shfl_xor(mr, 4)); mr = fmaxf(mr, __shfl_xor(mr, 2)); mr = fmaxf(mr, __shfl_xor(mr, 1));
        if (lane_ == 0) red[wave_] = mr;
        __syncthreads();
        const float mx = fmaxf(red[0], red[1]);
        const bool bad = (tid_ < 128) && !(fabsf(a - r) <= SELFCHECK_TOL * mx + 0.001f);
        if (bad) __hip_atomic_store(flag, 1u, __ATOMIC_RELAXED, __HIP_MEMORY_SCOPE_AGENT);
        __syncthreads();
    }
}
#endif

DI void moe_router(const Frame& F) {
    PHASE_IDS;
    unsigned char* ws = F.ws;
    const bf16_t* H = (const bf16_t*)(ws + O_H4B); const float* rw = inp(I_ROUTER); const float* gn = inp(I_FFN_NORM) + D;
    LAS bf16_t* wh = (LAS bf16_t*)F.lds;
    LAS bf16_t* wl = wh + 32 * 16 * 40;
    LAS unsigned* lcnt = (LAS unsigned*)(F.lds + 98304);
    for (int i = tid_; i < 32 * 16 * 32; i += 512) {
        const int kk = i & 31, e = (i >> 5) & 15, ks = i >> 9, k = ks * 32 + kk;
        float w = 0.f; if (e < NE) w = rw[k * NE + e] * gn[k];
        const unsigned hi = pk2(w, 0.f) & 0xffffu; const float wr = w - __uint_as_float(hi << 16);
        wh[(ks * 16 + e) * 40 + kk] = (bf16_t)hi; wl[(ks * 16 + e) * 40 + kk] = (bf16_t)(pk2(wr, 0.f) & 0xffffu);
    }
    if (tid_ < 8) lcnt[tid_] = 0u;
    __syncthreads();
    unsigned* top = (unsigned*)(ws + WS_TOP);
    const int fr = lane_ & 15, fq = lane_ >> 4;
    for (int r0 = (blockIdx.x * 8 + wave_) * 16; r0 < T; r0 += F.G * 128) {
        const bf16_t* hp = H + (size_t)(r0 + fr) * D + 8 * fq;
        bf16x8 av[32];
#pragma unroll
        for (int ks = 0; ks < 32; ++ks) av[ks] = *(const bf16x8*)(hp + ks * 32);
        f32x4 acc = {0.f, 0.f, 0.f, 0.f}; float ss = 0.f;
#pragma unroll
        for (int ks = 0; ks < 32; ++ks) {
            const bf16x8 bh = *(const LAS bf16x8*)(wh + (ks * 16 + fr) * 40 + 8 * fq), bl = *(const LAS bf16x8*)(wl + (ks * 16 + fr) * 40 + 8 * fq);
            acc = __builtin_amdgcn_mfma_f32_16x16x32_bf16(bh, av[ks], acc, 0, 0, 0);
            acc = __builtin_amdgcn_mfma_f32_16x16x32_bf16(bl, av[ks], acc, 0, 0, 0);
#pragma unroll
            for (int j = 0; j < 8; ++j) { const float v = __uint_as_float((unsigned)(unsigned short)av[ks][j] << 16); ss += v * v; }
        }
        ss += __shfl_xor(ss, 16); ss += __shfl_xor(ss, 32);
        float lg[8];
#pragma unroll
        for (int j = 0; j < 4; ++j) { const float o = __shfl_xor(acc[j], 16); lg[j] = acc[j]; lg[4 + j] = o; }
        if (fq == 0) {
            const int row = r0 + fr;
            const float rstd = __builtin_amdgcn_rsqf(ss * (1.0f / D) + EPS);
            int e1 = 0; float b1 = lg[0];
#pragma unroll
            for (int e = 1; e < 8; ++e) if (lg[e] > b1) { b1 = lg[e]; e1 = e; }
            int e2 = -1; float b2 = -3.0e38f;
#pragma unroll
            for (int e = 0; e < 8; ++e) if (e != e1 && lg[e] > b2) { b2 = lg[e]; e2 = e; }
            const float w1 = frcp(1.0f + fexp2((b2 - b1) * rstd * 1.4426950408889634f)), w2 = 1.0f - w1;
            unsigned* tp = top + (size_t)row * 8;
            tp[0] = (unsigned)e1; tp[1] = (unsigned)e2; tp[2] = __float_as_uint(w1); tp[3] = __float_as_uint(w2); tp[4] = __float_as_uint(rstd);
            lds_add(lcnt + e1, 1u); lds_add(lcnt + e2, 1u);
        }
    }
    __syncthreads();
    if (tid_ < 8) atomicAdd((unsigned*)(ws + ZO_CNT) + tid_, lcnt[tid_]);
}

DI void moe_slots(const Frame& F) {
    PHASE_IDS;
    unsigned char* ws = F.ws;
    const unsigned* CNT = (const unsigned*)(ws + ZO_CNT); unsigned* CNT2 = (unsigned*)(ws + ZO_CNT) + 64;
    const unsigned* top = (const unsigned*)(ws + WS_TOP);
    int* slot_tok = (int*)(ws + WS_SLOT); float* slot_rstd = (float*)(ws + WS_SLOT + 512 * KiB); float* slot_gate = (float*)(ws + WS_SLOT + 1024 * KiB); int* slot_dst = (int*)(ws + WS_SLOT + 1536 * KiB);
    LAS unsigned* lc = (LAS unsigned*)F.lds; LAS unsigned* gb = lc + 8; LAS unsigned* sb = lc + 16; LAS unsigned* cn = lc + 32;
    if (tid_ == 0) { unsigned a = 0; for (int e = 0; e < 8; ++e) { const unsigned c = CNT[e]; cn[e] = c; sb[e] = a; a += ((c + 255u) >> 8) << 8; } sb[8] = a; }
    if (tid_ < 8) lc[tid_] = 0u;
    __syncthreads();
    for (int chunk = blockIdx.x; chunk < T / 128; chunk += F.G) {
        int e = 0, tok = 0, k = 0; unsigned lpos = 0;
        if (tid_ < 256) { tok = chunk * 128 + (tid_ >> 1); k = tid_ & 1; e = (int)top[(size_t)tok * 8 + k]; lpos = lds_add(lc + e, 1u); }
        __syncthreads();
        if (tid_ < 8) gb[tid_] = sb[tid_] + atomicAdd(CNT2 + tid_, lc[tid_]);
        __syncthreads();
        if (tid_ < 256) {
            const unsigned slot = gb[e] + lpos;
            slot_tok[slot] = tok; slot_rstd[slot] = __uint_as_float(top[(size_t)tok * 8 + 4]); slot_gate[slot] = __uint_as_float(top[(size_t)tok * 8 + 2 + k]); slot_dst[slot] = tok * 2 + k;
        }
        __syncthreads();
        if (tid_ < 8) lc[tid_] = 0u;
        __syncthreads();
    }
    if (blockIdx.x == 0) {
        for (int e = 0; e < 8; ++e)
            for (unsigned sl = sb[e] + cn[e] + tid_; sl < sb[e + 1]; sl += 512) { slot_tok[sl] = 0; slot_rstd[sl] = 0.f; slot_gate[sl] = 0.f; slot_dst[sl] = -1; }
    }
}

DI void moe_combine(const Frame& F) {
    PHASE_IDS;
    unsigned char* ws = F.ws;
    bf16_t* H = (bf16_t*)(ws + O_H5B); const bf16_t* Y1 = (const bf16_t*)(ws + O_Y1); const bf16_t* Y2 = (const bf16_t*)(ws + O_Y2); float* SQ = (float*)(ws + ZO_SQ5);
    for (int row0 = (blockIdx.x * 8 + wave_) * 4; row0 < T; row0 += F.G * 32) {
        u32x4 hw[4][2], aw[4][2], cw[4][2];
#pragma unroll
        for (int q = 0; q < 4; ++q)
#pragma unroll
            for (int j = 0; j < 2; ++j) { const size_t base = (size_t)(row0 + q) * D + j * 512 + lane_ * 8; hw[q][j] = *(const u32x4*)(H + base); aw[q][j] = *(const u32x4*)(Y1 + base); cw[q][j] = *(const u32x4*)(Y2 + base); }
#pragma unroll
        for (int q = 0; q < 4; ++q) {
            float ss = 0.f, vv[2][8];
#pragma unroll
            for (int j = 0; j < 2; ++j) {
                const u32x4 h = hw[q][j], a = aw[q][j], c = cw[q][j]; float* v = vv[j];
                v[0] = bf_lo(h.x) + (bf_lo(a.x) + bf_lo(c.x)); v[1] = bf_hi(h.x) + (bf_hi(a.x) + bf_hi(c.x)); v[2] = bf_lo(h.y) + (bf_lo(a.y) + bf_lo(c.y)); v[3] = bf_hi(h.y) + (bf_hi(a.y) + bf_hi(c.y));
                v[4] = bf_lo(h.z) + (bf_lo(a.z) + bf_lo(c.z)); v[5] = bf_hi(h.z) + (bf_hi(a.z) + bf_hi(c.z)); v[6] = bf_lo(h.w) + (bf_lo(a.w) + bf_lo(c.w)); v[7] = bf_hi(h.w) + (bf_hi(a.w) + bf_hi(c.w));
                u32x4 w; w.x = pk2(v[0], v[1]); w.y = pk2(v[2], v[3]); w.z = pk2(v[4], v[5]); w.w = pk2(v[6], v[7]);
                *(u32x4*)(H + (size_t)(row0 + q) * D + j * 512 + lane_ * 8) = w;
#pragma unroll
                for (int e = 0; e < 8; ++e) ss += v[e] * v[e];
            }
            ss = wave_sum(ss);
            if (lane_ == 0) *(f32x4*)(SQ + (size_t)(row0 + q) * 4) = (f32x4){ss, 0.f, 0.f, 0.f};
            if (I8_PLE & 2) {
                float mx = 0.f;
#pragma unroll
                for (int j = 0; j < 2; ++j)
#pragma unroll
                    for (int e = 0; e < 8; ++e) mx = fmaxf(mx, fabsf(vv[j][e]));
                mx = fmaxf(mx, __shfl_xor(mx, 32)); mx = fmaxf(mx, __shfl_xor(mx, 16)); mx = fmaxf(mx, __shfl_xor(mx, 8)); mx = fmaxf(mx, __shfl_xor(mx, 4)); mx = fmaxf(mx, __shfl_xor(mx, 2)); mx = fmaxf(mx, __shfl_xor(mx, 1));
                mx = fmaxf(mx, 1e-20f);
                const float qs = 127.0f * frcp(mx);
                if (lane_ == 0) ((float*)(ws + ZO_RS5))[row0 + q] = mx * (1.0f / 127.0f) * __builtin_amdgcn_rsqf(ss * (1.0f / D) + EPS);
#pragma unroll
                for (int j = 0; j < 2; ++j)
                    *(u32x2*)(ws + O_H5I8 + (size_t)(row0 + q) * D + j * 512 + lane_ * 8) = (u32x2){pk4_i8(vv[j][0] * qs, vv[j][1] * qs, vv[j][2] * qs, vv[j][3] * qs), pk4_i8(vv[j][4] * qs, vv[j][5] * qs, vv[j][6] * qs, vv[j][7] * qs)};
            }
        }
    }
}

DI void final_norm(const Frame& F) {
    PHASE_IDS;
    const bf16_t* H = (const bf16_t*)(F.ws + O_H6B); float* out = F.out; const float* SQ = (const float*)(F.ws + ZO_SQ6); const float* g = inp(I_FINAL_NORM);
    f32x4 gv[2][2];
#pragma unroll
    for (int j = 0; j < 2; ++j) { gv[j][0] = *(const f32x4*)(g + j * 512 + lane_ * 8); gv[j][1] = *(const f32x4*)(g + j * 512 + lane_ * 8 + 4); }
#if SELFCHECK
    const float poison = (__hip_atomic_load((unsigned*)(F.ws + ZO_CNT) + 320, __ATOMIC_RELAXED, __HIP_MEMORY_SCOPE_AGENT) != 0u) ? __builtin_nanf("") : 0.f;
#else
    const float poison = 0.f;
#endif
    for (int row0 = (blockIdx.x * 8 + wave_) * 4; row0 < T; row0 += F.G * 32) {
        u32x4 hw[4][2]; float rv[4];
#pragma unroll
        for (int q = 0; q < 4; ++q) { const size_t base = (size_t)(row0 + q) * D + lane_ * 8; hw[q][0] = *(const u32x4*)(H + base); hw[q][1] = *(const u32x4*)(H + base + 512); rv[q] = pg8::sq_rstd(SQ, row0 + q); }
#pragma unroll
        for (int q = 0; q < 4; ++q)
#pragma unroll
            for (int j = 0; j < 2; ++j) { const u32x4 w = hw[q][j]; float* op = out + (size_t)(row0 + q) * D + j * 512 + lane_ * 8;
                *(f32x4*)op = (f32x4){bf_lo(w.x), bf_hi(w.x), bf_lo(w.y), bf_hi(w.y)} * rv[q] * gv[j][0] + poison;
                *(f32x4*)(op + 4) = (f32x4){bf_lo(w.z), bf_hi(w.z), bf_lo(w.w), bf_hi(w.w)} * rv[q] * gv[j][1]; }
    }
}

constexpr int NPH = 21;
__global__ void __launch_bounds__(512, 2) fwd_kernel(Args args) {
    extern __shared__ __attribute__((aligned(16))) unsigned char lds_raw[];
    Frame F;
    F.lds = (LAS unsigned char*)lds_raw;
    F.G = gridDim.x; { int wv = __builtin_amdgcn_readfirstlane((int)threadIdx.x >> 6); asm volatile("" : "+s"(wv)); F.wv = wv; }
    F.out = args.out; F.ws = args.ws;
    unsigned char* ws = args.ws;
    for (int u = threadIdx.x; u < (LDS_BYTES - LDSCTL_OFF) / 4; u += 512) ((LAS unsigned*)(F.lds + LDSCTL_OFF))[u] = 0u;
    __syncthreads();
    volatile LAS unsigned* MISC = (volatile LAS unsigned*)(F.lds + MISC_OFF);
    XcdBarrier bar; bar.bar = (unsigned*)(ws + ZO_BAR); bar.x = 0; bar.st = nullptr;
    if (MK_N_LAUNCHES == 1) bar = xcd_barrier_post((unsigned*)(ws + ZO_BAR), MISC + 8, threadIdx.x == 0);
    const int lo = args.ph_lo, hi = args.ph_hi;
#ifdef ONLY_PH
#define IN(k) ((k) == ONLY_PH && lo <= (k) && (k) < hi)
#else
#define IN(k) (lo <= (k) && (k) < hi)
#endif
#define SEAM(k) do { if (IN(k) && IN((k) + 1)) { xcd_barrier(bar, F.wv == 0 && lane_id() == 0); } } while (0)
    LAS unsigned char* ring = F.lds;
    LAS float* part = (LAS float*)(F.lds + TAB_OFF);
    const int G = F.G, cid = (int)blockIdx.x;
    using namespace pg8;

    if (IN(0)) { for (int rep = 0; rep < DUPN(1); ++rep) p0_prologue(F); } SEAM(0);

    if (IN(1)) {
        { int rot = 0;
            if (I8_UP) {
            conv_matrix_fp8(F, inp(I_W1), D, FF, ws + WO_F13, 0, 1, inp(I_FFN_NORM), 1.f, rot, (const float*)(ws + ZO_WMAX));
            conv_matrix_fp8(F, inp(I_W3), D, FF, ws + WO_F13, 0, 2, inp(I_FFN_NORM), 1.f, rot, (const float*)(ws + ZO_WMAX) + FF); }
            if (I8_PLE & 1) conv_matrix_fp8(F, inp(I_PLE_GATE), D, D, ws + WO_G0, 0, 0, inp(I_PLE_NORM), 1.f, rot, (const float*)(ws + ZO_WMG));
            if (I8_PLE & 2) conv_matrix_fp8(F, inp(I_PLE_GATE) + (size_t)D * D, D, D, ws + WO_G1, 0, 0, inp(I_PLE_NORM) + D, 1.f, rot, (const float*)(ws + ZO_WMG) + D);
            if (I8_QKV) {
                conv_matrix_fp8(F, inp(I_WQ), D, D, ws + WO_QK, 0, 0, inp(I_ATTN_NORM), 1.f, rot, (const float*)(ws + ZO_WMQKV));
                conv_matrix_fp8(F, inp(I_WK), D, D, ws + WO_QK, D, 0, inp(I_KV_NORM), 1.f, rot, (const float*)(ws + ZO_WMQKV) + D);
                conv_matrix_fp8(F, inp(I_WV), D, D, ws + WO_V, 0, 0, inp(I_KV_NORM), 1.f, rot, (const float*)(ws + ZO_WMQKV) + 2 * D); } }
        { Gemm g{(const bf16_t*)(ws + O_POOLED), (const bf16_t*)(ws + WO_POOL), 256, nullptr, F.wv}; OrdPool S; S.init(T / 256, 4, G, cid);
          EpiResid<false> E{inp(I_X), (bf16_t*)(ws + O_H1B), (float*)(ws + ZO_SQ1), part, (FP8_FFN0 & 1) ? ws + O_H1F8 : nullptr, I8_UP ? ws + O_H1I8 : nullptr, 1.f, SI8_H};
          gemm_phase<EpiResid<false>, OrdPool, false>(ring, g, S, E); }
        { Gemm g{(const bf16_t*)(ws + WS_PB), (const bf16_t*)(ws + WO_P0), PD, nullptr, F.wv}; OrdStd S; S.init(T / 256, 4, G, cid);
          EpiPP E{(bf16_t*)(ws + O_PP0)};
          gemm_phase<EpiPP, OrdStd, false>(ring, g, S, E); }
    } SEAM(1);

    if (IN(2)) {
        OrdStd S; S.init(T / 256, 2 * FF / 256, G, cid);
        constexpr bool A8 = (FP8_FFN0 & 1) != 0, O8 = (FP8_FFN0 & 2) != 0;
        if constexpr (I8_UP) {
            Gemm g{(const bf16_t*)(ws + O_H1I8), (const bf16_t*)(ws + WO_F13), D / 2, nullptr, F.wv};
            EpiSwiGLU<true, O8, true> E{(bf16_t*)(ws + O_ACT0), FF, (const float*)(ws + ZO_SQ1), 1.0f / SI8_H, (const float*)(ws + ZO_WMAX)};
            gemm_phase<EpiSwiGLU<true, O8, true>, OrdStd, false, false, true>(ring, g, S, E);
        } else {
        Gemm g{(const bf16_t*)(ws + (A8 ? O_H1F8 : O_H1B)), (const bf16_t*)(ws + WO_F13), A8 ? D / 2 : D, nullptr, F.wv};
        EpiSwiGLU<true, O8> E{(bf16_t*)(ws + O_ACT0), FF, (const float*)(ws + ZO_SQ1), A8 ? 1.0f / (S8_H * S8_W13) : 1.f, nullptr};
        gemm_phase<EpiSwiGLU<true, O8>, OrdStd, false, A8>(ring, g, S, E);
        }
    } SEAM(2);

    if (IN(3)) {
        constexpr bool A8 = (FP8_FFN0 & 2) != 0;
        Gemm g{(const bf16_t*)(ws + O_ACT0), (const bf16_t*)(ws + WO_F2), A8 ? FF / 2 : FF, nullptr, F.wv}; OrdStd S; S.init(T / 256, 4, G, cid);
        EpiResid<true> E{ws + O_H1B, (bf16_t*)(ws + O_H2B), (float*)(ws + ZO_SQ2), part, nullptr, (I8_PLE & 1) ? ws + O_H2I8 : nullptr, A8 ? 1.0f / (S8_ACT * S8_WF2) : 1.f, SI8_H3};
        gemm_phase<EpiResid<true>, OrdStd, false, A8>(ring, g, S, E);
    } SEAM(3);

    if (IN(4)) {
        constexpr bool G8 = (I8_PLE & 1) != 0;
        Gemm g{(const bf16_t*)(ws + (G8 ? O_H2I8 : O_H2B)), (const bf16_t*)(ws + WO_G0), G8 ? D / 2 : D, nullptr, F.wv}; OrdStd S; S.init(T / 256, 4, G, cid);
        EpiPLE<I8_QKV != 0, G8> E{(const bf16_t*)(ws + O_H2B), (const bf16_t*)(ws + O_PP0), (bf16_t*)(ws + O_H3B), (float*)(ws + ZO_SQ3), (const float*)(ws + ZO_SQ2), part, ws + O_H3F8,
                                  (const float*)(ws + ZO_WMG), nullptr};
        gemm_phase<EpiPLE<I8_QKV != 0, G8>, OrdStd, false, false, G8>(ring, g, S, E);
    } SEAM(4);

    if (IN(5)) {
        constexpr bool I8Q = I8_QKV != 0;
        const float* wmq = (const float*)(ws + ZO_WMQKV);
        const float qks = I8Q ? 1.0f / SI8_H3 : 1.f;
        { Gemm g{(const bf16_t*)(ws + (I8Q ? O_H3F8 : O_H3B)), (const bf16_t*)(ws + WO_QK), I8Q ? D / 2 : D, nullptr, F.wv}; OrdStd S; S.init(T / 256, 4, G, cid);
          EpiQK<false, I8Q> E{(bf16_t*)(ws + O_Q), ws + O_Q8, ws + O_K8, (const float*)(ws + ZO_SQ3), (const float*)(ws + WS_ROPE), (const float*)(ws + WS_ROPE) + SEQ * 16, (float*)(ws + ZO_KM), wmq, qks};
          gemm_phase<EpiQK<false, I8Q>, OrdStd, false, false, I8Q>(ring, g, S, E); }
        { Gemm g{(const bf16_t*)(ws + (I8Q ? O_H3F8 : O_H3B)), (const bf16_t*)(ws + WO_QK + (size_t)D * D * (I8Q ? 1 : 2)), I8Q ? D / 2 : D, nullptr, F.wv}; OrdStd S; S.init(T / 256, 4, G, cid);
          EpiQK<true, I8Q> E{(bf16_t*)(ws + O_Q), ws + O_Q8, ws + O_K8, (const float*)(ws + ZO_SQ3), (const float*)(ws + WS_ROPE), (const float*)(ws + WS_ROPE) + SEQ * 16, (float*)(ws + ZO_KM), wmq + D, qks};
          gemm_phase<EpiQK<true, I8Q>, OrdStd, false, false, I8Q>(ring, g, S, E); }
        { Gemm g{(const bf16_t*)(ws + WO_V), (const bf16_t*)(ws + O_H3F8), D / 2, nullptr, F.wv}; OrdStd S; S.init(4, T / 256, G, cid);
          EpiVT<I8Q> E{ws + O_VT8, (const float*)(ws + ZO_SQ3), wmq + 2 * D, I8Q ? 1.0f / SI8_H3 : 1.0f / (S8_H * S8_WKV)};
          gemm_phase<EpiVT<I8Q>, OrdStd, false, !I8Q, I8Q>(ring, g, S, E); }
    } SEAM(5);

    if (IN(6)) { moba_select(F);
#if SELFCHECK
        attn_selfcheck_ref(F);
#endif
    } SEAM(6);

    if (IN(7)) { moba_partial(F); } SEAM(7);
    if (IN(8)) { moba_combine(F); } SEAM(8);

    if (IN(9)) {
#if SELFCHECK
        attn_selfcheck_cmp(F); __syncthreads();
#endif
        { Gemm g{(const bf16_t*)(ws + O_Q), (const bf16_t*)(ws + WO_O), D, nullptr, F.wv}; OrdStd S; S.init(T / 256, 4, G, cid);
          EpiResid<true> E{ws + O_H3B, (bf16_t*)(ws + O_H4B), nullptr, part, ws + O_H4F8, nullptr, 1.f, 0.f};
          gemm_phase<EpiResid<true>, OrdStd, false>(ring, g, S, E); }
        for (int rep = 0; rep < DUPN(3); ++rep) conv_moe_weights(F);
    } SEAM(9);

    if (IN(10)) { moe_router(F); } SEAM(10);
    if (IN(11)) { moe_slots(F); } SEAM(11);

    {
        LAS int* cumt = (LAS int*)(F.lds + TAB_OFF + 4096);
        int ntiles = 0;
        if (hi > 12 && lo <= 12 + NCHUNK) {
            const unsigned* CNT = (const unsigned*)(ws + ZO_CNT);
            if (F.wv == 0 && lane_id() == 0) { int a = 0; for (int e = 0; e < 8; ++e) { cumt[e] = a; a += (int)((CNT[e] + 255u) >> 8); } cumt[8] = a; }
            __syncthreads();
            ntiles = cumt[8];
        }
        const int left = (ntiles >= 256 && ntiles <= 256 + MAXCT) ? ntiles - 256 : 0;
        for (int k = 0; k <= NCHUNK; ++k) {
            if (IN(12 + k)) {
                if (k >= 1) {
                    const int c = k - 1, t0 = (c == 0) ? 0 : left + 64 * (c - 1), ntc = (c == 0) ? left : 64;
                    if (ntc > 0) {
                        Gemm g{(const bf16_t*)(ws + O_ACT1 + (size_t)(c & 1) * RG), (const bf16_t*)(ws + O_WE2), EFF / 2, nullptr, F.wv};
                        OrdMoE S; S.init(t0, ntc, 4, G, cid, D, 1, cumt);
                        EpiMoE2 E{(const int*)(ws + WS_SLOT + 1536 * KiB), (const float*)(ws + WS_SLOT + 1024 * KiB), (bf16_t*)(ws + O_Y1), (bf16_t*)(ws + O_Y2), 1.0f / (S8_ACT * S8_W2)};
                        gemm_phase<EpiMoE2, OrdMoE, false, true>(ring, g, S, E);
                    }
                }
                if (k < NCHUNK) {
                    const int c = k, t0 = (c == 0) ? 0 : left + 64 * (c - 1), ntc = (c == 0) ? left : 64;
                    if (ntc > 0) {
                        Gemm g{(const bf16_t*)(ws + O_H4F8), (const bf16_t*)(ws + O_WE13), D / 2, (const int*)(ws + WS_SLOT), F.wv};
                        OrdMoE S; S.init(t0, ntc, 2 * EFF / 256, G, cid, 2 * EFF, 0, cumt, (k == 1) ? left : 0);
                        EpiSwiGLU<false, true> E{(bf16_t*)(ws + O_ACT1 + (size_t)(c & 1) * RG), EFF, (const float*)(ws + WS_SLOT + 512 * KiB), 1.0f / (S8_H * S8_W13), nullptr};
                        gemm_phase<EpiSwiGLU<false, true>, OrdMoE, true, true>(ring, g, S, E);
                    }
                }
            } SEAM(12 + k);
        }
    }

    if (IN(18)) {
        moe_combine(F);
        { Gemm g{(const bf16_t*)(ws + WS_PB) + (size_t)T * PD, (const bf16_t*)(ws + WO_P1), PD, nullptr, F.wv}; OrdStd S; S.init(T / 256, 4, G, cid);
          EpiPP E{(bf16_t*)(ws + O_PP1)};
          gemm_phase<EpiPP, OrdStd, false>(ring, g, S, E); }
    } SEAM(18);

    if (IN(19)) {
        constexpr bool G8 = (I8_PLE & 2) != 0;
        Gemm g{(const bf16_t*)(ws + (G8 ? O_H5I8 : O_H5B)), (const bf16_t*)(ws + WO_G1), G8 ? D / 2 : D, nullptr, F.wv}; OrdStd S; S.init(T / 256, 4, G, cid);
        EpiPLE<false, G8, G8> E{(const bf16_t*)(ws + O_H5B), (const bf16_t*)(ws + O_PP1), (bf16_t*)(ws + O_H6B), (float*)(ws + ZO_SQ6), (const float*)(ws + ZO_SQ5), part, nullptr,
                                (const float*)(ws + ZO_WMG) + D, (const float*)(ws + ZO_RS5)};
        gemm_phase<EpiPLE<false, G8, G8>, OrdStd, false, false, G8>(ring, g, S, E);
    } SEAM(19);

    if (IN(20)) { final_norm(F); }
#undef IN
#undef SEAM
}

extern "C" void kernel_launch(void* const* d_in, const int* in_sizes, int n_in, void* d_out, int out_size, void* d_ws, size_t ws_size, hipStream_t stream) {
    static int grid = 0;
    if (grid == 0) {
        if (n_in != 23 || in_sizes[0] != T * D || out_size != T * D || ws_size < WS_END) {
            fprintf(stderr, "kernel_launch: unexpected shapes or workspace (n_in %d, in0 %d, out %d, ws %zu, need %zu); nothing launched\n", n_in, n_in > 0 ? in_sizes[0] : -1, out_size, ws_size, (size_t)WS_END);
            grid = -1; return; }
        int dev = 0, cus = 0, per_cu = 0;
        if (hipGetDevice(&dev) != hipSuccess || hipDeviceGetAttribute(&cus, hipDeviceAttributeMultiprocessorCount, dev) != hipSuccess) { grid = -1; return; }
        if (hipFuncSetAttribute((const void*)fwd_kernel, hipFuncAttributeMaxDynamicSharedMemorySize, LDS_BYTES) != hipSuccess) { fprintf(stderr, "kernel_launch: hipFuncSetAttribute failed\n"); grid = -1; return; }
        if (hipOccupancyMaxActiveBlocksPerMultiprocessor(&per_cu, (const void*)fwd_kernel, 512, LDS_BYTES) != hipSuccess || per_cu < 1) { fprintf(stderr, "kernel_launch: occupancy query reports %d blocks per CU\n", per_cu); }
        (void)hipGetLastError();
        grid = cus;
    }
    if (grid < 0) return;
    if (hipMemsetAsync((char*)d_ws + WS_ZERO, 0, ZERO_BYTES, stream) != hipSuccess) { fprintf(stderr, "kernel_launch: memset failed\n"); return; }
    Args a{};
    for (int i = 0; i < 23; ++i) a.in[i] = (const float*)d_in[i];
    a.out = (float*)d_out; a.ws = (unsigned char*)d_ws;
    if (MK_N_LAUNCHES == 1) {
        a.ph_lo = 0; a.ph_hi = NPH;
        hipLaunchKernelGGL(fwd_kernel, dim3(grid), dim3(512), LDS_BYTES, stream, a);
    } else {
        for (int ph = 0; ph < NPH; ++ph) { a.ph_lo = ph; a.ph_hi = ph + 1; hipLaunchKernelGGL(fwd_kernel, dim3(grid), dim3(512), LDS_BYTES, stream, a); }
    }
    const hipError_t le = hipPeekAtLastError();
    if (le != hipSuccess) fprintf(stderr, "kernel_launch: launch failed: %s\n", hipGetErrorName(le));
}
```

```cpp
#include <hip/hip_runtime.h>
#include <cstdio>
#include <cstdint>

#define LAS __attribute__((address_space(3)))
#define DI __device__ __forceinline__
typedef unsigned short bf16_t;
typedef short bf16x8 __attribute__((ext_vector_type(8)));
typedef short s16x4 __attribute__((ext_vector_type(4)));
typedef float f32x4 __attribute__((ext_vector_type(4)));
typedef float f32x2 __attribute__((ext_vector_type(2)));
typedef float f32x16 __attribute__((ext_vector_type(16)));
typedef unsigned u32x4 __attribute__((ext_vector_type(4)));
typedef unsigned u32x2 __attribute__((ext_vector_type(2)));
typedef __bf16 bf16x2_t __attribute__((ext_vector_type(2)));
typedef int i32x4 __attribute__((ext_vector_type(4)));
typedef int i32x8 __attribute__((ext_vector_type(8)));

#ifndef PROBE_DUP
#define PROBE_DUP 0
#endif
#define DUPN(id) ((PROBE_DUP == (id)) ? 2 : 1)
#ifndef FP8_FFN0
#define FP8_FFN0 0
#endif
#ifndef SELFCHECK
#define SELFCHECK 0
#endif
#ifndef SELFCHECK_TOL
#define SELFCHECK_TOL 0.03f
#endif
#ifndef I8_UP
#define I8_UP 1
#endif
#ifndef I8_QKV
#define I8_QKV 1
#endif
#ifndef MK_N_LAUNCHES
#define MK_N_LAUNCHES 1
#endif

constexpr int BATCH = 2, SEQ = 16384, T = BATCH * SEQ, D = 1024, NH = 8, HD = 128, NBLK = 64;
constexpr int FF = 2816, EFF = 3584, NE = 8, PD = 256;
constexpr float EPS = 1e-6f;
constexpr float S8_H = 8.f, S8_W13 = 64.f, S8_ACT = 4.f, S8_W2 = 128.f, S8_WF2 = 64.f, S8_PO = 32.f, S8_QK = 16.f, S8_V = 16.f, S8_P = 256.f, S8_WKV = 64.f;
constexpr float SI8_H = 32.f;
constexpr float SI8_H3 = 24.f;
static_assert(S8_P == 256.f, "the attention softmax folds log2(S8_P) = 8 into its exponent");
constexpr int ATT_C = 6;
constexpr int NCHUNK = 5;
constexpr int MAXCT = 64;

constexpr size_t MiB = (size_t)1 << 20, KiB = 1024;
constexpr size_t WS_ZERO = 0, ZERO_BYTES = 1536 * KiB;
constexpr size_t ZO_BAR = 0;
constexpr size_t ZO_WMAX = 72 * KiB;
constexpr size_t ZO_WMQKV = ZO_WMAX + 2 * 2816 * 4;
constexpr size_t ZO_CNT = 64 * KiB;
constexpr size_t ZO_LCNT = 128 * KiB;
constexpr size_t ZO_SQ1 = 1536 * KiB, ZO_SQ2 = 2048 * KiB, ZO_SQ3 = 2560 * KiB, ZO_SQ5 = 3072 * KiB, ZO_SQ6 = 3584 * KiB;
constexpr size_t ZO_KM = 1 * MiB;
constexpr size_t WS_ROPE = 4 * MiB;
constexpr size_t WS_TOP = 6 * MiB;
constexpr size_t WS_SLOT = 7 * MiB;
constexpr size_t WS_WS = 9 * MiB;
constexpr size_t WO_POOL = WS_WS, WO_F13 = WO_POOL + MiB / 2, WO_F2 = WO_F13 + 11 * MiB, WO_G0 = WO_F2 + 11 * MiB / 2, WO_G1 = WO_G0 + 2 * MiB,
                 WO_P0 = WO_G1 + 2 * MiB, WO_P1 = WO_P0 + MiB / 2, WO_QK = WO_P1 + MiB / 2, WO_V = WO_QK + 4 * MiB, WO_O = WO_V + 2 * MiB;
constexpr size_t WS_PB = 39 * MiB;
constexpr size_t WS_R = 71 * MiB;
constexpr size_t RG = 64 * MiB;
constexpr size_t R_A = WS_R, R_B = WS_R + RG, R_C = WS_R + 2 * RG, R_D = WS_R + 3 * RG, R_E = WS_R + 4 * RG, R_G = WS_R + 5 * RG, R_I = WS_R + 6 * RG, R_J = WS_R + 7 * RG;
constexpr size_t WS_END = WS_R + 8 * RG;
static_assert(WO_O + 2 * MiB == WS_PB, "small weight map");
constexpr size_t O_H3F8 = R_J, O_H1I8 = R_J, O_H1F8 = R_J, O_POOLED = R_A, O_H1B = R_B, O_PP0 = R_C, O_ACT0 = R_D, O_H2B = R_A, O_H3B = R_B;
constexpr size_t O_Q = R_A, O_K8 = R_C, O_Q8 = R_C + 32 * MiB, O_VT8 = R_D, O_LIST = R_E, O_ML = R_E + 32 * MiB, O_PO = R_G;
constexpr size_t O_H4B = R_B, O_H4F8 = R_J, O_WE13 = R_I, O_WE2 = R_E, O_ACT1 = R_C, O_Y1 = R_A, O_Y2 = R_G, O_H5B = R_B, O_PP1 = R_C, O_H6B = R_A;

constexpr int RING_BYTES = 131072;
constexpr int LDSCTL_OFF = RING_BYTES;
constexpr int MISC_OFF = LDSCTL_OFF + 320;
constexpr int TAB_OFF = LDSCTL_OFF + 1024;
constexpr int LDS_BYTES = 147456;

DI unsigned pk2(float a, float b) { f32x2 v = {a, b}; return __builtin_bit_cast(unsigned, __builtin_convertvector(v, bf16x2_t)); }
DI unsigned pk4_fp8(float a, float b, float c, float d) {
    a = __builtin_amdgcn_fmed3f(a, -448.f, 448.f); b = __builtin_amdgcn_fmed3f(b, -448.f, 448.f); c = __builtin_amdgcn_fmed3f(c, -448.f, 448.f); d = __builtin_amdgcn_fmed3f(d, -448.f, 448.f);
    unsigned w = 0u; w = (unsigned)__builtin_amdgcn_cvt_pk_fp8_f32(a, b, (int)w, false); w = (unsigned)__builtin_amdgcn_cvt_pk_fp8_f32(c, d, (int)w, true); return w; }
DI unsigned pk4_i8(float a, float b, float c, float d) {
    const int ia = (int)__builtin_rintf(__builtin_amdgcn_fmed3f(a, -127.f, 127.f)), ib = (int)__builtin_rintf(__builtin_amdgcn_fmed3f(b, -127.f, 127.f));
    const int ic = (int)__builtin_rintf(__builtin_amdgcn_fmed3f(c, -127.f, 127.f)), id = (int)__builtin_rintf(__builtin_amdgcn_fmed3f(d, -127.f, 127.f));
    return ((unsigned)ia & 255u) | (((unsigned)ib & 255u) << 8) | (((unsigned)ic & 255u) << 16) | ((unsigned)id << 24); }
DI float bf_lo(unsigned u) { return __uint_as_float(u << 16); }
DI float bf_hi(unsigned u) { return __uint_as_float(u & 0xffff0000u); }
DI float fexp2(float x) { return __builtin_amdgcn_exp2f(x); }
DI float frcp(float x) { return __builtin_amdgcn_rcpf(x); }
DI float sigmoidf_(float a) { return frcp(1.0f + fexp2(-1.4426950408889634f * a)); }
DI unsigned lds_add(LAS unsigned* p, unsigned v) { return __hip_atomic_fetch_add(p, v, __ATOMIC_RELAXED, __HIP_MEMORY_SCOPE_WORKGROUP); }
DI int lane_id() { int r; asm volatile("v_mbcnt_lo_u32_b32 %0, -1, 0\n\tv_mbcnt_hi_u32_b32 %0, -1, %0" : "=v"(r)); return r; }
DI float wave_sum(float v) { v += __shfl_xor(v, 32); v += __shfl_xor(v, 16); v += __shfl_xor(v, 8); v += __shfl_xor(v, 4); v += __shfl_xor(v, 2); v += __shfl_xor(v, 1); return v; }

#define XB_TMO      128
#define XB_XCNT(j)  (256  + 64 * (j))
#define XB_XSUB(j)  (1280 + 64 * (j))
#define XB_XGEN(j)  (2304 + 64 * (j))
#define XB_TOP      3328
#define XB_TOPGEN   3392
#define XCD_BAR_WORDS 3456
#define XB_SPIN_CAP (1u << 18)
__device__ __forceinline__ unsigned xb_ld(unsigned* p)              { return __hip_atomic_load(p, __ATOMIC_RELAXED, __HIP_MEMORY_SCOPE_AGENT); }
__device__ __forceinline__ unsigned xb_add(unsigned* p, unsigned v) { return __hip_atomic_fetch_add(p, v, __ATOMIC_RELAXED, __HIP_MEMORY_SCOPE_AGENT); }
__device__ __forceinline__ unsigned xb_xcc_id() { return (unsigned)__builtin_amdgcn_s_getreg((3 << 11) | 20) & 0xFu; }
#define XB_SPIN(cond, bar) do { unsigned _sp = 0; while (cond) { __builtin_amdgcn_s_sleep(1); \
    if ((++_sp & 255u) == 0u) { if (xb_ld(&(bar)[XB_TMO])) break; if (_sp > XB_SPIN_CAP) { atomicAdd(&(bar)[XB_TMO], 1u); break; } } } } while (0)
struct XcdBarrier { unsigned* bar; unsigned x; volatile LAS unsigned* st; };
__device__ __forceinline__ XcdBarrier xcd_barrier_post(unsigned* bar, volatile LAS unsigned* st, bool leader) {
    XcdBarrier b; b.bar = bar; b.x = xb_xcc_id(); b.st = st;
    if (leader) (void)xb_add(&bar[XB_XCNT(b.x)], 1u);
    return b;
}
__device__ __forceinline__ void xcd_barrier_complete(unsigned* bar, unsigned x, unsigned& nloc, unsigned& nx) {
    const unsigned G = gridDim.x * gridDim.y * gridDim.z;
    unsigned sum, cnt, mine, sp = 0u;
    for (;;) {
        sum = 0u; cnt = 0u; mine = 0u;
#pragma unroll
        for (unsigned j = 0; j < 16; ++j) { const unsigned c = xb_ld(&bar[XB_XCNT(j)]); sum += c; cnt += (c > 0u) ? 1u : 0u; mine = (j == x) ? c : mine; }
        if (sum == G) break;
        __builtin_amdgcn_s_sleep(1);
        if ((++sp & 255u) == 0u) { if (xb_ld(&bar[XB_TMO])) break; if (sp > XB_SPIN_CAP) { atomicAdd(&bar[XB_TMO], 1u); break; } }
    }
    nloc = mine > 0u ? mine : 1u; nx = cnt > 0u ? cnt : 1u;
}
__device__ __forceinline__ void xcd_barrier(const XcdBarrier& b, bool leader) {
    asm volatile("s_waitcnt vmcnt(0)" ::: "memory");
    __syncthreads();
    if (leader) {
        unsigned* bar = b.bar;
        __builtin_amdgcn_s_waitcnt(0);
        unsigned nloc = b.st[0], nx = b.st[1];
        if (nloc == 0u) { xcd_barrier_complete(bar, b.x, nloc, nx); b.st[0] = nloc; b.st[1] = nx; }
        const unsigned old = xb_add(&bar[XB_XSUB(b.x)], 1u);
        const unsigned gen = old / nloc;
        if (old + 1u == (gen + 1u) * nloc) {
            __builtin_amdgcn_fence(__ATOMIC_RELEASE, "agent");
            asm volatile("s_waitcnt vmcnt(0)" ::: "memory");
            const unsigned og = xb_add(&bar[XB_TOP], 1u);
            const unsigned tg = og / nx;
            if (og + 1u == (tg + 1u) * nx) xb_add(&bar[XB_TOPGEN], 1u);
            else XB_SPIN(xb_ld(&bar[XB_TOPGEN]) == tg, bar);
            __builtin_amdgcn_fence(__ATOMIC_ACQUIRE, "agent");
            xb_add(&bar[XB_XGEN(b.x)], 1u);
            asm volatile("s_waitcnt vmcnt(0)" ::: "memory");
        } else {
            XB_SPIN(xb_ld(&bar[XB_XGEN(b.x)]) == gen, bar);
            __builtin_amdgcn_fence(__ATOMIC_ACQUIRE, "agent");
            asm volatile("s_waitcnt vmcnt(0)" ::: "memory");
        }
    }
    __syncthreads();
}

namespace pg8 {
constexpr int BM = 256, BK = 64, HALF = 128, HTB = HALF * BK * 2, NXCD = 8, WGM = 8;
__host__ __device__ __forceinline__ int lds_byte(int r, int c) { const int st = (r >> 4) * 2 + (c >> 5), rr = r & 15, cc = c & 31, ob = rr * 64 + cc * 2; return st * 1024 + (ob ^ (((ob >> 9) & 1) << 5)); }
__host__ __device__ __forceinline__ void stage_rc(int b, int& R, int& C) { const int st = b / 1024, sb = b % 1024, swz = sb ^ (((sb >> 9) & 1) << 5); R = (st >> 1) * 16 + swz / 64; C = (st & 1) * 32 + (swz % 64) / 2; }
__host__ __device__ __forceinline__ int perm32(int rho) { const int n = rho >> 4, i = rho & 15; return 8 * (i >> 2) + 4 * n + (i & 3); }

struct Unit { int pm, pn, arow, brow; };
struct Gemm { const bf16_t* A; const bf16_t* Bt; int K; const int* rowidx; int wv; };

struct TileOrder {
    int nM, nN, nwg, G, c;
    __device__ void init(int nM_, int nN_, int G_, int c_) { nM = nM_; nN = nN_; nwg = nM * nN; G = G_; c = c_; }
    __device__ bool tile(int i, int& pm, int& pn) const {
        const long L = (long)i * G + c; if (L >= nwg) return false;
        int wgid = (int)L; { const int q = nwg / NXCD, r = nwg % NXCD, xcd = wgid % NXCD, off = wgid / NXCD; wgid = (xcd < r ? xcd * (q + 1) : r * (q + 1) + (xcd - r) * q) + off; }
        const int nig = WGM * nN, gid = wgid / nig, fm = gid * WGM, gsz = (nM - fm) < WGM ? (nM - fm) : WGM;
        pm = fm + ((wgid % nig) % gsz); pn = (wgid % nig) / gsz; return true;
    }
};
struct OrdStd : TileOrder {
    __device__ bool next(int i, Unit& u) const { int pm, pn; if (!tile(i, pm, pn)) return false; u.pm = pm; u.pn = pn; u.arow = pm * BM; u.brow = pn * BM; return true; }
};
struct OrdPool : TileOrder {
    __device__ bool next(int i, Unit& u) const { int pm, pn; if (!tile(i, pm, pn)) return false; u.pm = pm; u.pn = pn; u.arow = pn * T + pm * BM; u.brow = pn * BM; return true; }
};
struct OrdMoE {
    int t0, ntc, npn, nb, nxc, xcd, rank, brow_e, second, light; const LAS int* cumt;
    __device__ __forceinline__ void init(int t0_, int ntc_, int npn_, int G, int c, int brow_e_, int second_, const LAS int* cumt_, int light_xcds = 0) {
        t0 = t0_; ntc = ntc_; npn = npn_; brow_e = brow_e_; second = second_; cumt = cumt_;
        if (G % 8 == 0) { nxc = 8; nb = G / 8; xcd = c % 8; rank = c / 8; } else { nxc = 1; nb = G; xcd = 0; rank = c; }
        light = (nxc == 8 && nb == 32 && xcd < light_xcds) ? 1 : 0;
    }
    __device__ __forceinline__ bool next(int i, Unit& u) const {
        const int nx = (ntc > xcd) ? (ntc - xcd + nxc - 1) / nxc : 0;
        const int nu = nx * npn;
        long j;
        if (light && nu == 224) {
            const int start = (rank < 4) ? 4 * rank : (rank < 16) ? 16 + 8 * (rank - 4) : 112 + 7 * (rank - 16);
            const int cnt = (rank < 4) ? 4 : (rank < 16) ? 8 : 7;
            if (i >= cnt) return false;
            j = start + i;
        } else { j = (long)i * nb + rank; if (j >= (long)nu) return false; }
        const int tlx = (int)(j % nx), pn = (int)(j / nx), tl = xcd + nxc * tlx, tile = t0 + tl;
        int e = 0;
#pragma unroll
        for (int k = 1; k < 8; ++k) e += (tile >= cumt[k]) ? 1 : 0;
        u.pn = pn; u.brow = e * brow_e + pn * BM;
        if (second) { u.pm = tile; u.arow = tl * BM; } else { u.pm = tl; u.arow = tile * BM; }
        return true;
    }
};

template <class Epi, class Sched, bool GATHER, bool FP8 = false, bool I8 = false>
__device__ __forceinline__ void gemm_phase(LAS unsigned char* lds, const Gemm g, const Sched& S, const Epi& E) {
    int wvv = g.wv; asm volatile("" : "+s"(wvv));
    int tid = wvv * 64 + lane_id(); asm volatile("" : "+v"(tid));
    const int wid = __builtin_amdgcn_readfirstlane(tid >> 6), lane = tid & 63, wr = wid >> 2, wc = wid & 3, fr = lane & 15, fq = lane >> 4;
    int K = g.K; asm volatile("" : "+s"(K)); const int nt = K / BK;
    unsigned voffA[2], voffB[2]; int RA[2]; unsigned CA[2];
#pragma unroll
    for (int i = 0; i < 2; ++i) { int R, C; stage_rc(tid * 16 + i * 8192, R, C); const int Rb = (R & ~31) + perm32(R & 31);
        voffA[i] = (unsigned)(R * K + C) * 2u; voffB[i] = (unsigned)(Rb * K + C) * 2u; RA[i] = R; CA[i] = (unsigned)C * 2u; }
    const size_t kstep = (size_t)(BK * 2);
    const size_t hstep = (size_t)HALF * K * 2;
    const unsigned hstepu = (unsigned)(HALF * K * 2);
    const size_t rstep = (size_t)K * 2;
    const unsigned ldsw = (unsigned)wid * 1024u;
    const int aoff = lds_byte(wr * 64 + fr, fq * 8), boff = lds_byte(wc * 32 + fr, fq * 8);
#define PG8_SA(b, h) (((b) * 2 + (h)) * HTB)
#define PG8_SB(b, h) ((4 + (b) * 2 + (h)) * HTB)
#define PG8_STAGE(bufoff, gbase, voff) do { _Pragma("unroll") for (int _i = 0; _i < 2; ++_i) \
        __builtin_amdgcn_global_load_lds((const unsigned*)((const char*)(gbase) + (voff)[_i]), (LAS unsigned*)(lds + (bufoff) + ldsw + _i * 8192), 16, 0, 0); } while (0)
#define PG8_CAT(a, b) __builtin_shufflevector(a, b, 0, 1, 2, 3, 4, 5, 6, 7)
#define PG8_LO(v) __builtin_bit_cast(bf16x8, __builtin_shufflevector(v, v, 0, 1, 2, 3))
#define PG8_HI(v) __builtin_bit_cast(bf16x8, __builtin_shufflevector(v, v, 4, 5, 6, 7))
#define PG8_LDA(dst, b, h) do { _Pragma("unroll") for (int m = 0; m < 4; ++m) dst[m] = PG8_CAT(*(const LAS i32x4*)(lds + PG8_SA(b, h) + aoff + m * 2048), *(const LAS i32x4*)(lds + PG8_SA(b, h) + aoff + m * 2048 + 1024)); } while (0)
#define PG8_LDB(dst, b, h) do { _Pragma("unroll") for (int n = 0; n < 2; ++n) dst[n] = PG8_CAT(*(const LAS i32x4*)(lds + PG8_SB(b, h) + boff + n * 2048), *(const LAS i32x4*)(lds + PG8_SB(b, h) + boff + n * 2048 + 1024)); } while (0)
#define PG8_MMAZ(ai, bj, At, Bt, Z) do { __builtin_amdgcn_s_setprio(1); \
        if constexpr (FP8) { _Pragma("unroll") for (int m = 0; m < 4; ++m) _Pragma("unroll") for (int n = 0; n < 2; ++n) { \
            if constexpr (Z) asm volatile("v_mfma_scale_f32_16x16x128_f8f6f4 %0, %1, %2, 0, %3, %3 op_sel_hi:[0,0,0]" : "=&v"(acc[ai][bj][m][n]) : "v"(Bt[n]), "v"(At[m]), "v"(one_e8m0)); \
            else asm volatile("v_mfma_scale_f32_16x16x128_f8f6f4 %0, %1, %2, %0, %3, %3 op_sel_hi:[0,0,0]" : "+v"(acc[ai][bj][m][n]) : "v"(Bt[n]), "v"(At[m]), "v"(one_e8m0)); } } \
        else if constexpr (I8) { \
            _Pragma("unroll") for (int m = 0; m < 4; ++m) _Pragma("unroll") for (int n = 0; n < 2; ++n) { \
                if constexpr (Z) asm volatile("v_mfma_i32_16x16x64_i8 %0, %1, %2, 0" : "=&v"(acc[ai][bj][m][n]) : "v"(__builtin_shufflevector(Bt[n], Bt[n], 0, 1, 2, 3)), "v"(__builtin_shufflevector(At[m], At[m], 0, 1, 2, 3))); \
                else asm volatile("v_mfma_i32_16x16x64_i8 %0, %1, %2, %0" : "+v"(acc[ai][bj][m][n]) : "v"(__builtin_shufflevector(Bt[n], Bt[n], 0, 1, 2, 3)), "v"(__builtin_shufflevector(At[m], At[m], 0, 1, 2, 3))); } \
            _Pragma("unroll") for (int m = 0; m < 4; ++m) _Pragma("unroll") for (int n = 0; n < 2; ++n) \
                asm volatile("v_mfma_i32_16x16x64_i8 %0, %1, %2, %0" : "+v"(acc[ai][bj][m][n]) : "v"(__builtin_shufflevector(Bt[n], Bt[n], 4, 5, 6, 7)), "v"(__builtin_shufflevector(At[m], At[m], 4, 5, 6, 7))); } \
        else {   \
            _Pragma("unroll") for (int m = 0; m < 4; ++m) _Pragma("unroll") for (int n = 0; n < 2; ++n) { \
                if constexpr (Z) asm volatile("v_mfma_f32_16x16x32_bf16 %0, %1, %2, 0" : "=&v"(acc[ai][bj][m][n]) : "v"(PG8_LO(Bt[n])), "v"(PG8_LO(At[m]))); \
                else asm volatile("v_mfma_f32_16x16x32_bf16 %0, %1, %2, %0" : "+v"(acc[ai][bj][m][n]) : "v"(PG8_LO(Bt[n])), "v"(PG8_LO(At[m]))); } \
            _Pragma("unroll") for (int m = 0; m < 4; ++m) _Pragma("unroll") for (int n = 0; n < 2; ++n) \
                asm volatile("v_mfma_f32_16x16x32_bf16 %0, %1, %2, %0" : "+v"(acc[ai][bj][m][n]) : "v"(PG8_HI(Bt[n])), "v"(PG8_HI(At[m]))); } \
        __builtin_amdgcn_s_setprio(0); } while (0)
#define PG8_WAIT_V(n) asm volatile("s_waitcnt vmcnt(" #n ")" ::: "memory")
#define PG8_WAIT_L(n) asm volatile("s_waitcnt lgkmcnt(" #n ")" ::: "memory")
#define PG8_BAR __builtin_amdgcn_s_barrier()
#define PG8_SCHED __builtin_amdgcn_sched_barrier(0)
#define PG8_AOFF(u, v0, v1) do { if constexpr (GATHER) { _Pragma("unroll") for (int _i = 0; _i < 2; ++_i) { \
            const unsigned r0 = (unsigned)g.rowidx[(u).arow + RA[_i]], r1 = (unsigned)g.rowidx[(u).arow + HALF + RA[_i]]; \
            v0[_i] = r0 * (unsigned)(K * 2) + CA[_i]; v1[_i] = r1 * (unsigned)(K * 2) + CA[_i]; } } \
        else { _Pragma("unroll") for (int _i = 0; _i < 2; ++_i) { v0[_i] = voffA[_i]; v1[_i] = voffA[_i] + hstepu; } } } while (0)
#define PG8_ABASE(u) (GATHER ? (const char*)g.A : (const char*)g.A + (size_t)(u).arow * rstep)
    Unit cur, nxt; int ui = 0;
    if (!S.next(0, cur)) return;
    f32x4 acc[2][2][4][2];
#define PG8_CLEAR() do { if constexpr (false) { _Pragma("unroll") for (int a = 0; a < 2; ++a) _Pragma("unroll") for (int b = 0; b < 2; ++b) _Pragma("unroll") for (int m = 0; m < 4; ++m) _Pragma("unroll") for (int n = 0; n < 2; ++n) \
        acc[a][b][m][n] = (f32x4){0.f, 0.f, 0.f, 0.f}; } } while (0)
    PG8_CLEAR();
    i32x8 At[4], B0[2], B1[2];
    const int one_e8m0 = 0x7F7F7F7F; (void)one_e8m0;
    unsigned cv0[2], cv1[2], nv0[2], nv1[2];
    PG8_AOFF(cur, cv0, cv1);
    const char* cA = PG8_ABASE(cur); const char* cB = (const char*)g.Bt + (size_t)cur.brow * rstep;
    PG8_STAGE(PG8_SB(0, 0), cB, voffB); PG8_STAGE(PG8_SB(0, 1), cB + hstep, voffB); PG8_STAGE(PG8_SA(0, 0), cA, cv0); PG8_STAGE(PG8_SA(0, 1), cA, cv1);
    if (wr == 1) PG8_BAR;
    PG8_WAIT_V(2); PG8_BAR;
    PG8_STAGE(PG8_SB(1, 0), cB + kstep, voffB); PG8_STAGE(PG8_SA(1, 0), cA + kstep, cv0); PG8_STAGE(PG8_SB(1, 1), cB + hstep + kstep, voffB);
    PG8_WAIT_V(6); PG8_BAR;
    for (;;) {
        const bool has_next = S.next(ui + 1, nxt);
        const char* nA = cA; const char* nB = cB;
#pragma unroll
        for (int i = 0; i < 2; ++i) { nv0[i] = cv0[i]; nv1[i] = cv1[i]; }
        if (has_next) { nA = PG8_ABASE(nxt); nB = (const char*)g.Bt + (size_t)nxt.brow * rstep; PG8_AOFF(nxt, nv0, nv1); }
#define PG8_KITER(t, Z) do { \
            const bool last = ((t) == nt - 2); \
            const char* a1 = cA + (size_t)((t) + 1) * kstep; \
            const char* a2 = last ? nA : cA + (size_t)((t) + 2) * kstep; const char* b2 = last ? nB : cB + (size_t)((t) + 2) * kstep; \
            const char* a3 = a2 + kstep; const char* b3 = b2 + kstep; \
            unsigned s0[2], s1[2]; \
            _Pragma("unroll") for (int i = 0; i < 2; ++i) { s0[i] = last ? nv0[i] : cv0[i]; s1[i] = last ? nv1[i] : cv1[i]; } \
              \
            PG8_LDB(B0, 0, 0); PG8_LDB(B1, 0, 1); PG8_SCHED; PG8_LDA(At, 0, 0); PG8_STAGE(PG8_SA(1, 1), a1, cv1); \
            PG8_WAIT_V(8); PG8_WAIT_L(0); PG8_BAR; PG8_MMAZ(0, 0, At, B0, Z); PG8_MMAZ(0, 1, At, B1, Z); PG8_BAR; PG8_SCHED; \
              \
            PG8_LDA(At, 0, 1); PG8_STAGE(PG8_SB(0, 0), b2, voffB); PG8_STAGE(PG8_SB(0, 1), b2 + hstep, voffB); PG8_STAGE(PG8_SA(0, 0), a2, s0); \
            PG8_WAIT_V(8); PG8_WAIT_L(0); PG8_BAR; PG8_MMAZ(1, 0, At, B0, Z); PG8_MMAZ(1, 1, At, B1, Z); PG8_BAR; PG8_SCHED; \
              \
            PG8_LDB(B0, 1, 0); PG8_LDB(B1, 1, 1); PG8_SCHED; PG8_LDA(At, 1, 0); PG8_STAGE(PG8_SA(0, 1), a2, s1); \
            PG8_WAIT_V(8); PG8_WAIT_L(0); PG8_BAR; PG8_MMAZ(0, 0, At, B0, false); PG8_MMAZ(0, 1, At, B1, false); PG8_BAR; PG8_SCHED; \
              \
            PG8_LDA(At, 1, 1); PG8_STAGE(PG8_SB(1, 0), b3, voffB); PG8_STAGE(PG8_SB(1, 1), b3 + hstep, voffB); PG8_STAGE(PG8_SA(1, 0), a3, s0); \
            PG8_WAIT_V(8); PG8_WAIT_L(0); PG8_BAR; PG8_MMAZ(1, 0, At, B0, false); PG8_MMAZ(1, 1, At, B1, false); PG8_BAR; PG8_SCHED; \
        } while (0)
        PG8_KITER(0, true);
        for (int t = 2; t < nt; t += 2) PG8_KITER(t, false);
        asm volatile("s_nop 7\n\ts_nop 7\n\ts_nop 7" ::: "memory");
        if (wr == 0) PG8_BAR;
        E(acc, cur, wr, wc, fr, fq);
        if (!has_next) break;
        PG8_CLEAR();
        cur = nxt; cA = nA; cB = nB; ++ui;
#pragma unroll
        for (int i = 0; i < 2; ++i) { cv0[i] = nv0[i]; cv1[i] = nv1[i]; }
        if (wr == 1) PG8_BAR;
    }
    PG8_WAIT_V(0);
    PG8_BAR;
#undef PG8_SA
#undef PG8_SB
#undef PG8_STAGE
#undef PG8_LDA
#undef PG8_LDB
#undef PG8_MMAZ
#undef PG8_KITER
#undef PG8_CLEAR
#undef PG8_CAT
#undef PG8_LO
#undef PG8_HI
#undef PG8_WAIT_V
#undef PG8_WAIT_L
#undef PG8_BAR
#undef PG8_SCHED
#undef PG8_AOFF
#undef PG8_ABASE
}

typedef f32x4 Acc[2][2][4][2];

DI void sq_store(LAS float* part, float* sq, const Unit& u, int wr, int wc, int fr, int fq) {
    asm volatile("s_waitcnt lgkmcnt(0)" ::: "memory"); __builtin_amdgcn_s_barrier(); asm volatile("" ::: "memory");
    const int t = (wr * 4 + wc) * 64 + fq * 16 + fr;
    if (t < 256) { const f32x4 p = *(const LAS f32x4*)(part + t * 4); sq[(size_t)(u.pm * BM + t) * 4 + u.pn] = (p[0] + p[1]) + (p[2] + p[3]); }
}
DI float sq_rstd(const float* sq, int row) { const f32x4 p = *(const f32x4*)(sq + (size_t)row * 4); return __builtin_amdgcn_rsqf(((p[0] + p[1]) + (p[2] + p[3])) * (1.0f / D) + EPS); }

template <bool RIN_BF16> struct EpiResid {
    const void* rin; bf16_t* hb; float* sq; LAS float* part; unsigned char* h8; unsigned char* hi8; float ascale;
    DI void operator()(const Acc& acc, const Unit& u, int wr, int wc, int fr, int fq) const {
        const int row0 = u.pm * BM + wr * 64 + fr, col0 = u.pn * BM + wc * 32 + 8 * fq;
#pragma unroll
        for (int ai = 0; ai < 2; ++ai) {
            f32x4 ra[4][2], rb[4][2];
#pragma unroll
            for (int m = 0; m < 4; ++m) { const size_t base = (size_t)(row0 + ai * HALF + m * 16) * D + col0;
#pragma unroll
                for (int bj = 0; bj < 2; ++bj) {
                    if constexpr (RIN_BF16) { const u32x4 rw = *(const u32x4*)((const bf16_t*)rin + base + bj * HALF);
                        ra[m][bj] = (f32x4){bf_lo(rw.x), bf_hi(rw.x), bf_lo(rw.y), bf_hi(rw.y)}; rb[m][bj] = (f32x4){bf_lo(rw.z), bf_hi(rw.z), bf_lo(rw.w), bf_hi(rw.w)}; }
                    else { const float* rp = (const float*)rin + base + bj * HALF; ra[m][bj] = *(const f32x4*)rp; rb[m][bj] = *(const f32x4*)(rp + 4); } } }
#pragma unroll
            for (int m = 0; m < 4; ++m) {
                const int row = row0 + ai * HALF + m * 16; const size_t base = (size_t)row * D + col0; float ss = 0.f;
#pragma unroll
                for (int bj = 0; bj < 2; ++bj) {
                    const f32x4 a = ra[m][bj] + acc[ai][bj][m][0] * ascale, b = rb[m][bj] + acc[ai][bj][m][1] * ascale;
                    { u32x4 w; w.x = pk2(a[0], a[1]); w.y = pk2(a[2], a[3]); w.z = pk2(b[0], b[1]); w.w = pk2(b[2], b[3]); *(u32x4*)(hb + base + bj * HALF) = w; }
                    if (h8) { u32x2 w; w.x = pk4_fp8(a[0] * S8_H, a[1] * S8_H, a[2] * S8_H, a[3] * S8_H); w.y = pk4_fp8(b[0] * S8_H, b[1] * S8_H, b[2] * S8_H, b[3] * S8_H); *(u32x2*)(h8 + base + bj * HALF) = w; }
                    if (hi8) *(u32x2*)(hi8 + base + bj * HALF) = (u32x2){pk4_i8(a[0] * SI8_H, a[1] * SI8_H, a[2] * SI8_H, a[3] * SI8_H), pk4_i8(b[0] * SI8_H, b[1] * SI8_H, b[2] * SI8_H, b[3] * SI8_H)};
                    ss += (a[0] * a[0] + a[1] * a[1]) + (a[2] * a[2] + a[3] * a[3]) + (b[0] * b[0] + b[1] * b[1]) + (b[2] * b[2] + b[3] * b[3]);
                }
                if (sq) { ss += __shfl_xor(ss, 16); ss += __shfl_xor(ss, 32); if (fq == 0) part[(wr * 64 + fr + ai * HALF + m * 16) * 4 + wc] = ss; }
            }
        }
        if (sq) sq_store(part, sq, u, wr, wc, fr, fq);
    }
};

template <bool RS_IS_SQ, bool FP8OUT = false, bool ACCI8 = false> struct EpiSwiGLU {
    bf16_t* out; int ldo; const float* rs; float ascale; const float* wmax;
    DI void operator()(const Acc& acc, const Unit& u, int wr, int wc, int fr, int fq) const {
        const int lr0 = wr * 64 + fr;
        f32x4 dq0[2], dq1[2];
        if constexpr (ACCI8) { const int c0 = u.pn * HALF + wc * 32 + 8 * fq;
#pragma unroll
            for (int n = 0; n < 2; ++n) { dq0[n] = *(const f32x4*)(wmax + c0 + 4 * n) * (1.0f / 127.0f); dq1[n] = *(const f32x4*)(wmax + FF + c0 + 4 * n) * (1.0f / 127.0f); } }
        float rvs[2][4];
#pragma unroll
        for (int ai = 0; ai < 2; ++ai)
#pragma unroll
            for (int m = 0; m < 4; ++m) { const int lr = lr0 + ai * HALF + m * 16; rvs[ai][m] = (RS_IS_SQ ? sq_rstd(rs, u.arow + lr) : rs[u.arow + lr]) * ascale; }
#pragma unroll
        for (int ai = 0; ai < 2; ++ai)
#pragma unroll
            for (int m = 0; m < 4; ++m) {
                const int lr = lr0 + ai * HALF + m * 16;
                const float rv = rvs[ai][m];
                const float rvo = FP8OUT ? rv * S8_ACT : rv, rvn = rv * -1.4426950408889634f;
                float gv[8];
#pragma unroll
                for (int n = 0; n < 2; ++n)
#pragma unroll
                    for (int e2 = 0; e2 < 2; ++e2) {
                        f32x2 x0 = {acc[ai][0][m][n][2 * e2], acc[ai][0][m][n][2 * e2 + 1]}, x1 = {acc[ai][1][m][n][2 * e2], acc[ai][1][m][n][2 * e2 + 1]};
                        if constexpr (ACCI8) { x0 = (f32x2){(float)__float_as_int(x0.x) * dq0[n][2 * e2], (float)__float_as_int(x0.y) * dq0[n][2 * e2 + 1]};
                                               x1 = (f32x2){(float)__float_as_int(x1.x) * dq1[n][2 * e2], (float)__float_as_int(x1.y) * dq1[n][2 * e2 + 1]}; }
                        const f32x2 t = x0 * rvn, ab = (x0 * rvo) * (x1 * rv);
                        f32x2 d; d.x = fexp2(t.x); d.y = fexp2(t.y); d = d + 1.0f;
                        f32x2 r; r.x = frcp(d.x); r.y = frcp(d.y);
                        const f32x2 g = ab * r;
                        gv[n * 4 + 2 * e2] = g.x; gv[n * 4 + 2 * e2 + 1] = g.y;
                    }
                if constexpr (FP8OUT) {
                    u32x2 w; w.x = pk4_fp8(gv[0], gv[1], gv[2], gv[3]); w.y = pk4_fp8(gv[4], gv[5], gv[6], gv[7]);
                    *(u32x2*)((unsigned char*)out + (size_t)(u.pm * BM + lr) * ldo + u.pn * HALF + wc * 32 + 8 * fq) = w;
                } else {
                    u32x4 w; w.x = pk2(gv[0], gv[1]); w.y = pk2(gv[2], gv[3]); w.z = pk2(gv[4], gv[5]); w.w = pk2(gv[6], gv[7]);
                    *(u32x4*)(out + (size_t)(u.pm * BM + lr) * ldo + u.pn * HALF + wc * 32 + 8 * fq) = w;
                }
            }
    }
};

template <bool I8COPY = false> struct EpiPLE {
    const bf16_t* hin; const bf16_t* pp; bf16_t* hout; float* sqout; const float* sqin; LAS float* part; unsigned char* h8;
    DI void operator()(const Acc& acc, const Unit& u, int wr, int wc, int fr, int fq) const {
        const int row0 = u.pm * BM + wr * 64 + fr, col0 = u.pn * BM + wc * 32 + 8 * fq;
#pragma unroll
        for (int ai = 0; ai < 2; ++ai) {
            u32x4 pws[4][2], hws[4][2]; float rvs[4];
#pragma unroll
            for (int m = 0; m < 4; ++m) { const int row = row0 + ai * HALF + m * 16; const size_t base = (size_t)row * D + col0; rvs[m] = sq_rstd(sqin, row);
#pragma unroll
                for (int bj = 0; bj < 2; ++bj) { pws[m][bj] = *(const u32x4*)(pp + base + bj * HALF); hws[m][bj] = *(const u32x4*)(hin + base + bj * HALF); } }
#pragma unroll
            for (int m = 0; m < 4; ++m) {
                const int row = row0 + ai * HALF + m * 16; const size_t base = (size_t)row * D + col0; float ss = 0.f;
                const float rv = rvs[m];
#pragma unroll
                for (int bj = 0; bj < 2; ++bj) {
                    const u32x4 pw = pws[m][bj], hw = hws[m][bj];
                    f32x4 a = (f32x4){bf_lo(hw.x), bf_hi(hw.x), bf_lo(hw.y), bf_hi(hw.y)}, b = (f32x4){bf_lo(hw.z), bf_hi(hw.z), bf_lo(hw.w), bf_hi(hw.w)};
                    const f32x4 g0 = acc[ai][bj][m][0] * rv, g1 = acc[ai][bj][m][1] * rv;
                    a[0] += sigmoidf_(g0[0]) * bf_lo(pw.x); a[1] += sigmoidf_(g0[1]) * bf_hi(pw.x); a[2] += sigmoidf_(g0[2]) * bf_lo(pw.y); a[3] += sigmoidf_(g0[3]) * bf_hi(pw.y);
                    b[0] += sigmoidf_(g1[0]) * bf_lo(pw.z); b[1] += sigmoidf_(g1[1]) * bf_hi(pw.z); b[2] += sigmoidf_(g1[2]) * bf_lo(pw.w); b[3] += sigmoidf_(g1[3]) * bf_hi(pw.w);
                    { u32x4 w; w.x = pk2(a[0], a[1]); w.y = pk2(a[2], a[3]); w.z = pk2(b[0], b[1]); w.w = pk2(b[2], b[3]); *(u32x4*)(hout + base + bj * HALF) = w; }
                    if (h8) { if constexpr (I8COPY) *(u32x2*)(h8 + base + bj * HALF) = (u32x2){pk4_i8(a[0] * SI8_H3, a[1] * SI8_H3, a[2] * SI8_H3, a[3] * SI8_H3), pk4_i8(b[0] * SI8_H3, b[1] * SI8_H3, b[2] * SI8_H3, b[3] * SI8_H3)};
                              else *(u32x2*)(h8 + base + bj * HALF) = (u32x2){pk4_fp8(a[0] * S8_H, a[1] * S8_H, a[2] * S8_H, a[3] * S8_H), pk4_fp8(b[0] * S8_H, b[1] * S8_H, b[2] * S8_H, b[3] * S8_H)}; }
                    ss += (a[0] * a[0] + a[1] * a[1]) + (a[2] * a[2] + a[3] * a[3]) + (b[0] * b[0] + b[1] * b[1]) + (b[2] * b[2] + b[3] * b[3]);
                }
                ss += __shfl_xor(ss, 16); ss += __shfl_xor(ss, 32); if (fq == 0) part[(wr * 64 + fr + ai * HALF + m * 16) * 4 + wc] = ss;
            }
        }
        sq_store(part, sqout, u, wr, wc, fr, fq);
    }
};

DI f32x4 cvt4i(const f32x4& v) { return (f32x4){(float)__float_as_int(v[0]), (float)__float_as_int(v[1]), (float)__float_as_int(v[2]), (float)__float_as_int(v[3])}; }
template <bool ISK, bool ACCI8 = false> struct EpiQK {
    bf16_t* q; unsigned char* q8; unsigned char* k8; const float* sqin; const float* cs; const float* sn; float* km; const float* wmax; float ascale;
    DI void operator()(Acc& acc, const Unit& u, int wr, int wc, int fr, int fq) const {
        constexpr bool isk = ISK; unsigned char* dst8 = isk ? k8 : q8; const int pnl = u.pn;
        const int row0 = u.pm * BM + wr * 64 + fr, col0 = pnl * BM + wc * 32 + 8 * fq;
        f32x4 csum[2][2];
#pragma unroll
        for (int bj = 0; bj < 2; ++bj)
#pragma unroll
            for (int n = 0; n < 2; ++n) csum[bj][n] = (f32x4){0.f, 0.f, 0.f, 0.f};
        float rvs[2][4];
#pragma unroll
        for (int ai = 0; ai < 2; ++ai)
#pragma unroll
            for (int m = 0; m < 4; ++m) rvs[ai][m] = sq_rstd(sqin, row0 + ai * HALF + m * 16) * ascale;
        if constexpr (ACCI8) {
#pragma unroll
            for (int bj = 0; bj < 2; ++bj)
#pragma unroll
                for (int n = 0; n < 2; ++n) { const f32x4 dq = *(const f32x4*)(wmax + col0 + bj * HALF + 4 * n) * (1.0f / 127.0f);
#pragma unroll
                    for (int ai = 0; ai < 2; ++ai)
#pragma unroll
                        for (int m = 0; m < 4; ++m) acc[ai][bj][m][n] = cvt4i(acc[ai][bj][m][n]) * (dq * rvs[ai][m]); } }
#define QK_ACC(n_) (ACCI8 ? acc[ai][bj][m][n_] : acc[ai][bj][m][n_] * rv)
        if (wc == 0) {
#pragma unroll
            for (int rp = 0; rp < 4; ++rp) {
                const int ai = rp >> 1, mb = 2 * (rp & 1);
                f32x4 c0s[2], c1s[2], s0s[2], s1s[2];
#pragma unroll
                for (int mm = 0; mm < 2; ++mm) { const int pos = (row0 + ai * HALF + (mb + mm) * 16) & (SEQ - 1); const float* cp = cs + pos * 16 + 8 * (fq & 1); const float* sp = sn + pos * 16 + 8 * (fq & 1);
                    c0s[mm] = *(const f32x4*)cp; c1s[mm] = *(const f32x4*)(cp + 4); s0s[mm] = *(const f32x4*)sp; s1s[mm] = *(const f32x4*)(sp + 4); }
#pragma unroll
                for (int mm = 0; mm < 2; ++mm) {
                    const int m = mb + mm; const size_t base = (size_t)(row0 + ai * HALF + m * 16) * D + col0; const float rv = rvs[ai][m];
#pragma unroll
                    for (int bj = 0; bj < 2; ++bj) {
                        f32x4 a = QK_ACC(0), b = QK_ACC(1), pa, pb;
#pragma unroll
                        for (int e = 0; e < 4; ++e) { pa[e] = __shfl_xor(a[e], 32); pb[e] = __shfl_xor(b[e], 32); }
                        if (fq < 2) { a = a * c0s[mm] - pa * s0s[mm]; b = b * c1s[mm] - pb * s1s[mm]; } else { a = a * c0s[mm] + pa * s0s[mm]; b = b * c1s[mm] + pb * s1s[mm]; }
                        if constexpr (!ISK) { u32x4 w; w.x = pk2(a[0], a[1]); w.y = pk2(a[2], a[3]); w.z = pk2(b[0], b[1]); w.w = pk2(b[2], b[3]); *(u32x4*)(q + base + bj * HALF) = w; }
                        *(u32x2*)(dst8 + base + bj * HALF) = (u32x2){pk4_fp8(a[0] * S8_QK, a[1] * S8_QK, a[2] * S8_QK, a[3] * S8_QK), pk4_fp8(b[0] * S8_QK, b[1] * S8_QK, b[2] * S8_QK, b[3] * S8_QK)};
                        if constexpr (ISK) { csum[bj][0] += a; csum[bj][1] += b; }
                    }
                }
            }
        } else {
#pragma unroll
            for (int ai = 0; ai < 2; ++ai)
#pragma unroll
                for (int m = 0; m < 4; ++m) {
                    const size_t base = (size_t)(row0 + ai * HALF + m * 16) * D + col0; const float rv = rvs[ai][m];
#pragma unroll
                    for (int bj = 0; bj < 2; ++bj) {
                        const f32x4 a = QK_ACC(0), b = QK_ACC(1);
                        if constexpr (!ISK) { u32x4 w; w.x = pk2(a[0], a[1]); w.y = pk2(a[2], a[3]); w.z = pk2(b[0], b[1]); w.w = pk2(b[2], b[3]); *(u32x4*)(q + base + bj * HALF) = w; }
                        *(u32x2*)(dst8 + base + bj * HALF) = (u32x2){pk4_fp8(a[0] * S8_QK, a[1] * S8_QK, a[2] * S8_QK, a[3] * S8_QK), pk4_fp8(b[0] * S8_QK, b[1] * S8_QK, b[2] * S8_QK, b[3] * S8_QK)};
                        if constexpr (ISK) { csum[bj][0] += a; csum[bj][1] += b; }
                    }
                }
        }
        if constexpr (ISK) {
            const int bb = u.pm >> 6, blk = u.pm & 63;
#pragma unroll
            for (int bj = 0; bj < 2; ++bj)
#pragma unroll
                for (int n = 0; n < 2; ++n)
#pragma unroll
                    for (int e = 0; e < 4; ++e) {
                        float v = csum[bj][n][e];
                        v += __shfl_xor(v, 1); v += __shfl_xor(v, 2); v += __shfl_xor(v, 4); v += __shfl_xor(v, 8);
                        if (fr == 0) unsafeAtomicAdd(km + (size_t)((bb * NH + pnl * 2 + bj) * NBLK + blk) * HD + wc * 32 + 8 * fq + 4 * n + e, v);
                    }
        }
#undef QK_ACC
    }
};

template <bool ACCI8 = false> struct EpiVT {
    unsigned char* vt; const float* sqin; const float* wmax; float ascale;
    DI void operator()(const Acc& acc, const Unit& u, int wr, int wc, int fr, int fq) const {
        const int row0 = u.pm * BM + wr * 64 + fr, col0 = u.pn * BM + wc * 32 + 8 * fq;
        f32x4 r0[2], r1[2];
#pragma unroll
        for (int bj = 0; bj < 2; ++bj)
#pragma unroll
            for (int e = 0; e < 4; ++e) { r0[bj][e] = sq_rstd(sqin, col0 + bj * HALF + e); r1[bj][e] = sq_rstd(sqin, col0 + bj * HALF + 4 + e); }
#pragma unroll
        for (int ai = 0; ai < 2; ++ai)
#pragma unroll
            for (int m = 0; m < 4; ++m) {
                const int row = row0 + ai * HALF + m * 16;
                const float dqr = ACCI8 ? wmax[row] * (S8_V * ascale / 127.0f) : S8_V * ascale;
#pragma unroll
                for (int bj = 0; bj < 2; ++bj) {
                    const f32x4 a = (ACCI8 ? cvt4i(acc[ai][bj][m][0]) : acc[ai][bj][m][0]) * (r0[bj] * dqr), b = (ACCI8 ? cvt4i(acc[ai][bj][m][1]) : acc[ai][bj][m][1]) * (r1[bj] * dqr);
                    *(u32x2*)(vt + (size_t)row * T + col0 + bj * HALF) = (u32x2){pk4_fp8(a[0], a[1], a[2], a[3]), pk4_fp8(b[0], b[1], b[2], b[3])};
                }
            }
    }
};

struct EpiPP {
    bf16_t* out;
    DI void operator()(const Acc& acc, const Unit& u, int wr, int wc, int fr, int fq) const {
        const int row0 = u.pm * BM + wr * 64 + fr, col0 = u.pn * BM + wc * 32 + 8 * fq;
#pragma unroll
        for (int ai = 0; ai < 2; ++ai)
#pragma unroll
            for (int m = 0; m < 4; ++m) {
                const size_t base = (size_t)(row0 + ai * HALF + m * 16) * D + col0;
#pragma unroll
                for (int bj = 0; bj < 2; ++bj) { const f32x4 a = acc[ai][bj][m][0], b = acc[ai][bj][m][1];
                    u32x4 w; w.x = pk2(a[0], a[1]); w.y = pk2(a[2], a[3]); w.z = pk2(b[0], b[1]); w.w = pk2(b[2], b[3]);
                    *(u32x4*)(out + base + bj * HALF) = w; }
            }
    }
};

struct EpiMoE2 {
    const int* dst; const float* gate; bf16_t* y1; bf16_t* y2; float gs;
    DI void operator()(const Acc& acc, const Unit& u, int wr, int wc, int fr, int fq) const {
        const int s0 = u.pm * BM + wr * 64 + fr, col0 = u.pn * BM + wc * 32 + 8 * fq;
        int ds[2][4]; float gvs[2][4];
#pragma unroll
        for (int ai = 0; ai < 2; ++ai)
#pragma unroll
            for (int m = 0; m < 4; ++m) { const int slot = s0 + ai * HALF + m * 16; ds[ai][m] = dst[slot]; gvs[ai][m] = gate[slot] * gs; }
#pragma unroll
        for (int ai = 0; ai < 2; ++ai)
#pragma unroll
            for (int m = 0; m < 4; ++m) {
                const int d = ds[ai][m]; const float gv = gvs[ai][m];
                if (d >= 0) {
                    bf16_t* yb = ((d & 1) ? y2 : y1) + (size_t)(d >> 1) * D + col0;
#pragma unroll
                    for (int bj = 0; bj < 2; ++bj) { const f32x4 a = acc[ai][bj][m][0] * gv, b = acc[ai][bj][m][1] * gv;
                        u32x4 w; w.x = pk2(a[0], a[1]); w.y = pk2(a[2], a[3]); w.z = pk2(b[0], b[1]); w.w = pk2(b[2], b[3]);
                        *(u32x4*)(yb + bj * HALF) = w; }
                }
            }
    }
};
}

struct Args { const float* in[23]; float* out; unsigned char* ws; int ph_lo, ph_hi; };
struct Frame {
    LAS unsigned char* lds; int G, wv;
    float* out; unsigned char* ws;
};
#define PHASE_IDS int wvv_ = F.wv; asm volatile("" : "+s"(wvv_)); int tid_ = wvv_ * 64 + lane_id(); asm volatile("" : "+v"(tid_)); const int lane_ = tid_ & 63, wave_ = __builtin_amdgcn_readfirstlane(tid_ >> 6); (void)lane_; (void)wave_
DI const float* inp(int i) { const char* ka = (const char*)__builtin_amdgcn_kernarg_segment_ptr(); asm volatile("" : "+s"(ka)); return *(const float* const*)(ka + 8 * i); }
enum { I_X = 0, I_P, I_POOL_NORM, I_POOL_W, I_POOL_SCALE, I_KV_NORM, I_WK, I_WV, I_ATTN_NORM, I_WQ, I_WO, I_FFN_NORM, I_W1, I_W3, I_W2, I_ROUTER, I_EW1, I_EW3, I_EW2,
       I_PLE_NORM, I_PLE_GATE, I_PLE_PROJ, I_FINAL_NORM };

DI void conv_matrix(const Frame& F, const float* src, int Ks, int Ns, bf16_t* dst, int rbase, int mode, const float* gain, const float* cscale, int& rot) {
    PHASE_IDS;
    LAS bf16_t* tile = (LAS bf16_t*)F.lds;
    const int ntk = Ks >> 6, ntn = Ns >> 6, ntiles = ntk * ntn;
    const int ty = tid_ >> 4, tx = tid_ & 15, wn = tid_ >> 3, wk = tid_ & 7;
    int first = (int)blockIdx.x - rot; if (first < 0) first += F.G;
    for (int tl0 = first; tl0 < ntiles; tl0 += 4 * F.G) {
        f32x4 v[4][2];
#pragma unroll
        for (int q = 0; q < 4; ++q) { const int tl = (tl0 + q * F.G < ntiles) ? tl0 + q * F.G : tl0; const int k0 = (tl % ntk) << 6, n0 = (tl / ntk) << 6;
#pragma unroll
            for (int i = 0; i < 2; ++i) v[q][i] = *(const f32x4*)(src + (size_t)(k0 + ty + 32 * i) * Ns + n0 + 4 * tx); }
#pragma unroll
        for (int q = 0; q < 4; ++q) { const int tl = (tl0 + q * F.G < ntiles) ? tl0 + q * F.G : tl0; const int k0 = (tl % ntk) << 6, n0 = (tl / ntk) << 6;
#pragma unroll
            for (int i = 0; i < 2; ++i) { const int k = ty + 32 * i; f32x4 x = v[q][i];
                if (gain) x = x * gain[k0 + k];
                if (cscale) x = x * *(const f32x4*)(cscale + n0 + 4 * tx);
#pragma unroll
                for (int e = 0; e < 4; ++e) tile[q * 4608 + (4 * tx + e) * 72 + k] = (bf16_t)(pk2(x[e], 0.f) & 0xffffu); } }
        __syncthreads();
#pragma unroll
        for (int q = 0; q < 4; ++q) if (tl0 + q * F.G < ntiles) { const int tl = tl0 + q * F.G; const int k0 = (tl % ntk) << 6, n0 = (tl / ntk) << 6;
            const int n = n0 + wn; const int drow = (mode == 0) ? rbase + n : rbase + (n >> 7) * 256 + (mode - 1) * 128 + (n & 127);
            *(u32x4*)(dst + (size_t)drow * Ks + k0 + wk * 8) = *(const LAS u32x4*)(tile + q * 4608 + wn * 72 + wk * 8); }
        __syncthreads();
    }
    rot = (rot + ntiles) % F.G;
}

DI void conv_matrix_fp8(const Frame& F, const float* src, int Ks, int Ns, unsigned char* dst, int rbase, int mode, const float* gain, float scale, int& rot, const float* colmax = nullptr) {
    PHASE_IDS;
    LAS unsigned char* tile = F.lds;
    const int ntk = Ks >> 7, ntn = Ns >> 6, ntiles = ntk * ntn;
    const int ty = tid_ >> 4, tx = tid_ & 15, wn = tid_ >> 3, wk = tid_ & 7;
    int first = (int)blockIdx.x - rot; if (first < 0) first += F.G;
    for (int tl = first; tl < ntiles; tl += 2 * F.G) {
        const int tl2 = tl + F.G; const bool two = tl2 < ntiles;
        const int k0 = (tl % ntk) << 7, n0 = (tl / ntk) << 6, k1 = two ? (tl2 % ntk) << 7 : k0, n1 = two ? (tl2 / ntk) << 6 : n0;
        f32x4 v[4], w[4];
#pragma unroll
        for (int i = 0; i < 4; ++i) { const int k = 4 * ty + i; v[i] = *(const f32x4*)(src + (size_t)(k0 + k) * Ns + n0 + 4 * tx); w[i] = *(const f32x4*)(src + (size_t)(k1 + k) * Ns + n1 + 4 * tx); }
#pragma unroll
        for (int i = 0; i < 4; ++i) { const int k = 4 * ty + i; v[i] = v[i] * (gain ? gain[k0 + k] * scale : scale); w[i] = w[i] * (gain ? gain[k1 + k] * scale : scale); }
        if (colmax) {
            f32x4 c0 = *(const f32x4*)(colmax + n0 + 4 * tx), c1 = *(const f32x4*)(colmax + n1 + 4 * tx);
#pragma unroll
            for (int e = 0; e < 4; ++e) { c0[e] = 127.0f * frcp(fmaxf(c0[e], 1e-30f)); c1[e] = 127.0f * frcp(fmaxf(c1[e], 1e-30f)); }
#pragma unroll
            for (int i = 0; i < 4; ++i) { v[i] = v[i] * c0; w[i] = w[i] * c1; }
#pragma unroll
            for (int e = 0; e < 4; ++e) { *(LAS unsigned*)(tile + (4 * tx + e) * 144 + 4 * ty) = pk4_i8(v[0][e], v[1][e], v[2][e], v[3][e]);
                                          *(LAS unsigned*)(tile + 9216 + (4 * tx + e) * 144 + 4 * ty) = pk4_i8(w[0][e], w[1][e], w[2][e], w[3][e]); }
        } else {
#pragma unroll
        for (int e = 0; e < 4; ++e) { *(LAS unsigned*)(tile + (4 * tx + e) * 144 + 4 * ty) = pk4_fp8(v[0][e], v[1][e], v[2][e], v[3][e]);
                                      *(LAS unsigned*)(tile + 9216 + (4 * tx + e) * 144 + 4 * ty) = pk4_fp8(w[0][e], w[1][e], w[2][e], w[3][e]); }
        }
        __syncthreads();
        { const int n = n0 + wn; const int drow = (mode == 0) ? rbase + n : rbase + (n >> 7) * 256 + (mode - 1) * 128 + (n & 127);
          *(u32x4*)(dst + (size_t)drow * Ks + k0 + wk * 16) = *(const LAS u32x4*)(tile + wn * 144 + wk * 16); }
        if (two) { const int n = n1 + wn; const int drow = (mode == 0) ? rbase + n : rbase + (n >> 7) * 256 + (mode - 1) * 128 + (n & 127);
          *(u32x4*)(dst + (size_t)drow * Ks + k1 + wk * 16) = *(const LAS u32x4*)(tile + 9216 + wn * 144 + wk * 16); }
        __syncthreads();
    }
    rot = (rot + ntiles) % F.G;
}

DI void sincos_acc(float ang, float& c, float& s) {
    const double a = (double)ang;
    const double q = __builtin_rint(a * 0.63661977236758134308);
    double r = __builtin_fma(-q, 1.57079632679489655800e+00, a); r = __builtin_fma(-q, 6.12323399573676603587e-17, r);
    const double r2 = r * r;
    double sp = -7.6471637318198164759e-13; sp = sp * r2 + 1.6059043836821614599e-10; sp = sp * r2 - 2.5052108385441718775e-08; sp = sp * r2 + 2.7557319223985890653e-06;
    sp = sp * r2 - 1.9841269841269841270e-04; sp = sp * r2 + 8.3333333333333333333e-03; sp = sp * r2 - 1.6666666666666666667e-01; const double sr = r + r * r2 * sp;
    double cp = 4.7794773323873852974e-14; cp = cp * r2 - 1.1470745597729724714e-11; cp = cp * r2 + 2.0876756987868098979e-09; cp = cp * r2 - 2.7557319223985890653e-07;
    cp = cp * r2 + 2.4801587301587301587e-05; cp = cp * r2 - 1.3888888888888888889e-03; cp = cp * r2 + 4.1666666666666666667e-02; cp = cp * r2 - 0.5; const double cr = 1.0 + r2 * cp;
    const int qi = (int)((long long)q & 3);
    const double sv = (qi == 0) ? sr : (qi == 1) ? cr : (qi == 2) ? -sr : -cr;
    const double cv = (qi == 0) ? cr : (qi == 1) ? -sr : (qi == 2) ? -cr : sr;
    c = (float)cv; s = (float)sv;
}

DI void colmax_pass(const Frame& F, const float* src, int Ns, const float* gain, unsigned* wmax, int& rot) {
    PHASE_IDS;
    const int njobs = (Ns >> 8) * 32;
    int first = (int)blockIdx.x - rot; if (first < 0) first += F.G;
    for (int job = first; job < njobs; job += F.G) {
        const int cb = job >> 5, rb = job & 31;
        const int n = cb * 256 + (tid_ & 255), r0 = rb * 32 + (tid_ >> 8) * 16;
        float mx = 0.f;
#pragma unroll
        for (int i = 0; i < 16; ++i) mx = fmaxf(mx, fabsf(src[(size_t)(r0 + i) * Ns + n] * gain[r0 + i]));
        atomicMax(wmax + n, __float_as_uint(mx));
    }
    rot = (rot + njobs) % F.G;
}

DI void p0_prologue(const Frame& F) {
    PHASE_IDS;
    unsigned char* ws = F.ws;
    int rot = 0;
    for (int g = 0; g < 4; ++g) conv_matrix(F, inp(I_POOL_W) + (size_t)g * 65536, 256, 256, (bf16_t*)(ws + WO_POOL), g * 256, 0, nullptr, inp(I_POOL_SCALE) + g * 256, rot);
    if (FP8_FFN0 & 1) { conv_matrix_fp8(F, inp(I_W1), D, FF, ws + WO_F13, 0, 1, inp(I_FFN_NORM), S8_W13, rot); conv_matrix_fp8(F, inp(I_W3), D, FF, ws + WO_F13, 0, 2, inp(I_FFN_NORM), S8_W13, rot); }
    else if (I8_UP) {
        colmax_pass(F, inp(I_W1), FF, inp(I_FFN_NORM), (unsigned*)(ws + ZO_WMAX), rot);
        colmax_pass(F, inp(I_W3), FF, inp(I_FFN_NORM), (unsigned*)(ws + ZO_WMAX) + FF, rot);
    }
    else { conv_matrix(F, inp(I_W1), D, FF, (bf16_t*)(ws + WO_F13), 0, 1, inp(I_FFN_NORM), nullptr, rot); conv_matrix(F, inp(I_W3), D, FF, (bf16_t*)(ws + WO_F13), 0, 2, inp(I_FFN_NORM), nullptr, rot); }
    if (FP8_FFN0 & 2) conv_matrix_fp8(F, inp(I_W2), FF, D, ws + WO_F2, 0, 0, nullptr, S8_WF2, rot);
    else conv_matrix(F, inp(I_W2), FF, D, (bf16_t*)(ws + WO_F2), 0, 0, nullptr, nullptr, rot);
    conv_matrix(F, inp(I_PLE_GATE), D, D, (bf16_t*)(ws + WO_G0), 0, 0, inp(I_PLE_NORM), nullptr, rot);
    conv_matrix(F, inp(I_PLE_GATE) + (size_t)D * D, D, D, (bf16_t*)(ws + WO_G1), 0, 0, inp(I_PLE_NORM) + D, nullptr, rot);
    conv_matrix(F, inp(I_PLE_PROJ), PD, D, (bf16_t*)(ws + WO_P0), 0, 0, nullptr, nullptr, rot);
    conv_matrix(F, inp(I_PLE_PROJ) + (size_t)PD * D, PD, D, (bf16_t*)(ws + WO_P1), 0, 0, nullptr, nullptr, rot);
    if (I8_QKV) {
        colmax_pass(F, inp(I_WQ), D, inp(I_ATTN_NORM), (unsigned*)(ws + ZO_WMQKV), rot);
        colmax_pass(F, inp(I_WK), D, inp(I_KV_NORM), (unsigned*)(ws + ZO_WMQKV) + D, rot);
        colmax_pass(F, inp(I_WV), D, inp(I_KV_NORM), (unsigned*)(ws + ZO_WMQKV) + 2 * D, rot);
    } else {
    conv_matrix(F, inp(I_WQ), D, D, (bf16_t*)(ws + WO_QK), 0, 0, inp(I_ATTN_NORM), nullptr, rot);
    conv_matrix(F, inp(I_WK), D, D, (bf16_t*)(ws + WO_QK), D, 0, inp(I_KV_NORM), nullptr, rot);
    conv_matrix_fp8(F, inp(I_WV), D, D, ws + WO_V, 0, 0, inp(I_KV_NORM), S8_WKV, rot);
    }
    conv_matrix(F, inp(I_WO), D, D, (bf16_t*)(ws + WO_O), 0, 0, nullptr, nullptr, rot);
    {
        const float* p = inp(I_P); bf16_t* pb = (bf16_t*)(ws + WS_PB);
        const size_t n8 = (size_t)2 * T * PD / 8;
        for (size_t i = (size_t)blockIdx.x * 512 + tid_; i < n8; i += (size_t)F.G * 512) {
            const f32x4 a = *(const f32x4*)(p + i * 8), b = *(const f32x4*)(p + i * 8 + 4);
            u32x4 w; w.x = pk2(a[0], a[1]); w.y = pk2(a[2], a[3]); w.z = pk2(b[0], b[1]); w.w = pk2(b[2], b[3]);
            *(u32x4*)(pb + i * 8) = w;
        }
    }
    {
        float* cs = (float*)(ws + WS_ROPE); float* sn = cs + SEQ * 16;
        for (int i = blockIdx.x * 512 + tid_; i < SEQ * 16; i += F.G * 512) {
            const int pos = i >> 4, f = i & 15;
            const float inv = __uint_as_float(f == 0 ? 0x3f800000u : 0u) + ((f == 1) ? 4.403665960e-01f : (f == 2) ? 1.939227432e-01f : (f == 3) ? 8.539710194e-02f : (f == 4) ? 3.760603070e-02f :
                (f == 5) ? 1.656044088e-02f : (f == 6) ? 7.292664610e-03f : (f == 7) ? 3.211446106e-03f : (f == 8) ? 1.414213562e-03f : (f == 9) ? 6.227724371e-04f : (f == 10) ? 2.742481884e-04f :
                (f == 11) ? 1.207697351e-04f : (f == 12) ? 5.318295734e-05f : (f == 13) ? 2.341999971e-05f : (f == 14) ? 1.031338525e-05f : (f == 15) ? 4.541670478e-06f : 0.f);
            const float ang = (float)pos * inv;
            float c, s; sincos_acc(ang, c, s); cs[i] = c; sn[i] = s;
        }
    }
    {
        LAS float* rsl = (LAS float*)(F.lds + 65536);
        const float* x = inp(I_X); const float* pg = inp(I_POOL_NORM);
        bf16_t* pooled = (bf16_t*)(ws + O_POOLED);
        for (int tile = blockIdx.x; tile < T / 128; tile += F.G) {
            const int s0 = tile * 128, p0 = s0 & (SEQ - 1), halo = p0 < 15 ? p0 : 15;
            for (int r0 = wave_; r0 < halo + 128; r0 += 32) {
                f32x4 v[4][4];
#pragma unroll
                for (int q = 0; q < 4; ++q) { const int r = r0 + 8 * q; const int rc = r < halo + 128 ? r : halo + 127;
                    const float* xp = x + (size_t)(s0 - halo + rc) * D + lane_ * 4;
#pragma unroll
                    for (int j = 0; j < 4; ++j) v[q][j] = *(const f32x4*)(xp + j * 256); }
                float ss[4];
#pragma unroll
                for (int q = 0; q < 4; ++q) { float a = 0.f;
#pragma unroll
                    for (int j = 0; j < 4; ++j) a += (v[q][j][0] * v[q][j][0] + v[q][j][1] * v[q][j][1]) + (v[q][j][2] * v[q][j][2] + v[q][j][3] * v[q][j][3]);
                    ss[q] = a; }
#pragma unroll
                for (int q = 0; q < 4; ++q) ss[q] = wave_sum(ss[q]);
#pragma unroll
                for (int q = 0; q < 4; ++q) { const int r = r0 + 8 * q; if (lane_ == 0 && r < halo + 128) rsl[15 - halo + r] = __builtin_amdgcn_rsqf(ss[q] * (1.0f / D) + EPS); }
            }
            __syncthreads();
            {
                const int g = wave_ & 3, half = wave_ >> 2, W = 2 << g;
                const int cb = g * 256 + lane_ * 4;
                const f32x4 gn = *(const f32x4*)(pg + cb);
                const int ss0 = s0 + half * 64, ps0 = p0 + half * 64;
                const float* xc = x + cb;
                f32x4 sum = (f32x4){0.f, 0.f, 0.f, 0.f};
                for (int i = 1; i < W; ++i) if (ps0 - i >= 0) sum += *(const f32x4*)(xc + (size_t)(ss0 - i) * D) * (rsl[ss0 - i - s0 + 15] * gn);
                bf16_t* op = pooled + ((size_t)g * T + ss0) * 256 + lane_ * 4;
#pragma unroll 1
                for (int c8 = 0; c8 < 8; ++c8) {
                    f32x4 cur[8], old[8];
#pragma unroll
                    for (int i = 0; i < 8; ++i) { const int r = c8 * 8 + i, s = ss0 + r, pos = ps0 + r;
                        cur[i] = *(const f32x4*)(xc + (size_t)s * D);
                        const int so = (pos - W + 1 >= 0) ? s - W + 1 : s;
                        old[i] = *(const f32x4*)(xc + (size_t)so * D); }
#pragma unroll
                    for (int i = 0; i < 8; ++i) { const int r = c8 * 8 + i, s = ss0 + r, pos = ps0 + r;
                        const f32x4 cv = cur[i] * (rsl[s - s0 + 15] * gn);
                        sum += cv;
                        const int cnt = (pos + 1 < W) ? pos + 1 : W;
                        const f32x4 o = sum * frcp((float)cnt) - cv;
                        u32x2 w; w.x = pk2(o[0], o[1]); w.y = pk2(o[2], o[3]);
                        *(u32x2*)(op + (size_t)r * 256) = w;
                        if (pos - W + 1 >= 0) sum -= old[i] * (rsl[s - W + 1 - s0 + 15] * gn); }
                }
            }
            __syncthreads();
        }
    }
}

DI void conv_moe_weights(const Frame& F) {
    unsigned char* ws = F.ws; int rot = 0;
    for (int e = 0; e < NE; ++e) {
        conv_matrix_fp8(F, inp(I_EW1) + (size_t)e * D * EFF, D, EFF, ws + O_WE13, e * 2 * EFF, 1, inp(I_FFN_NORM) + D, S8_W13, rot);
        conv_matrix_fp8(F, inp(I_EW3) + (size_t)e * D * EFF, D, EFF, ws + O_WE13, e * 2 * EFF, 2, inp(I_FFN_NORM) + D, S8_W13, rot);
        conv_matrix_fp8(F, inp(I_EW2) + (size_t)e * EFF * D, EFF, D, ws + O_WE2, e * D, 0, nullptr, S8_W2, rot);
    }
}

DI bool sel_better(float v, int i, float w, int k) { return (v > w) || (v == w && i < k); }
DI void sel_insert(float v, int i, float& v0, int& i0, float& v1, int& i1, float& v2, int& i2) {
    const bool b0 = sel_better(v, i, v0, i0), b1 = sel_better(v, i, v1, i1), b2 = sel_better(v, i, v2, i2);
    const float n2 = b1 ? v1 : (b2 ? v : v2), n1 = b0 ? v0 : (b1 ? v : v1), n0 = b0 ? v : v0;
    const int m2 = b1 ? i1 : (b2 ? i : i2), m1 = b0 ? i0 : (b1 ? i : i1), m0 = b0 ? i : i0;
    v0 = n0; v1 = n1; v2 = n2; i0 = m0; i1 = m1; i2 = m2;
}
DI void moba_select(const Frame& F) {
    PHASE_IDS;
    unsigned char* ws = F.ws;
    const bf16_t* Q = (const bf16_t*)(ws + O_Q); const float* KM = (const float*)(ws + ZO_KM);
    unsigned* LCNT = (unsigned*)(ws + ZO_LCNT); unsigned short* LIST = (unsigned short*)(ws + O_LIST);
    LAS bf16_t* kh = (LAS bf16_t*)F.lds;
    LAS bf16_t* kl = kh + 64 * 136;
    LAS unsigned* lcnt = (LAS unsigned*)(F.lds + 49152); LAS unsigned* lbase = lcnt + 64;
    const int fr = lane_ & 15, fq = lane_ >> 4;
    for (int unit = blockIdx.x; unit < BATCH * NH * 32; unit += F.G) {
        const int b = unit >> 8, h = (unit >> 5) & 7, c = b ? 31 - (unit & 31) : (unit & 31);
        const int jmax = 2 * c + 1;
        for (int idx = tid_; idx < 64 * 32; idx += 512) {
            const int n = idx >> 5, d4 = idx & 31;
            f32x4 v = (f32x4){0.f, 0.f, 0.f, 0.f};
            if (n < jmax) v = *(const f32x4*)(KM + (size_t)((b * NH + h) * NBLK + n) * HD + d4 * 4) * (1.0f / 256.0f);
            unsigned hi[4], lo[4];
#pragma unroll
            for (int e = 0; e < 4; ++e) { hi[e] = pk2(v[e], 0.f) & 0xffffu; lo[e] = pk2(v[e] - __uint_as_float(hi[e] << 16), 0.f) & 0xffffu; }
            *(LAS u32x2*)(kh + n * 136 + d4 * 4) = (u32x2){hi[0] | (hi[1] << 16), hi[2] | (hi[3] << 16)};
            *(LAS u32x2*)(kl + n * 136 + d4 * 4) = (u32x2){lo[0] | (lo[1] << 16), lo[2] | (lo[3] << 16)};
        }
        if (tid_ < 64) lcnt[tid_] = 0u;
        __syncthreads();
        int selv[4]; unsigned lpv[4];
#pragma unroll
        for (int gi = 0; gi < 4; ++gi) {
            const int s = c * 512 + (wave_ * 4 + gi) * 16 + fr;
            const int j = (c * 512 + (wave_ * 4 + gi) * 16) >> 8;
            const bf16_t* qp = Q + ((size_t)(b * SEQ + s)) * D + h * HD + 8 * fq;
            bf16x8 qf[4];
#pragma unroll
            for (int ks = 0; ks < 4; ++ks) qf[ks] = *(const bf16x8*)(qp + 32 * ks);
            f32x4 acc[4];
#pragma unroll
            for (int nt = 0; nt < 4; ++nt) { acc[nt] = (f32x4){0.f, 0.f, 0.f, 0.f};
#pragma unroll
                for (int ks = 0; ks < 4; ++ks) {
                    const bf16x8 ah = *(const LAS bf16x8*)(kh + (16 * nt + fr) * 136 + 32 * ks + 8 * fq), al = *(const LAS bf16x8*)(kl + (16 * nt + fr) * 136 + 32 * ks + 8 * fq);
                    acc[nt] = __builtin_amdgcn_mfma_f32_16x16x32_bf16(ah, qf[ks], acc[nt], 0, 0, 0);
                    acc[nt] = __builtin_amdgcn_mfma_f32_16x16x32_bf16(al, qf[ks], acc[nt], 0, 0, 0);
                } }
            float v0 = -3.0e38f, v1 = -3.0e38f, v2 = -3.0e38f; int i0 = 1000, i1 = 1001, i2 = 1002;
#pragma unroll
            for (int nt = 0; nt < 4; ++nt)
#pragma unroll
                for (int e = 0; e < 4; ++e) { const int n = 16 * nt + 4 * fq + e; if (n < j) sel_insert(acc[nt][e], n, v0, i0, v1, i1, v2, i2); }
#pragma unroll
            for (int sti = 0; sti < 2; ++sti) { const int st = 16 << sti;
                const float w0 = __shfl_xor(v0, st), w1 = __shfl_xor(v1, st), w2 = __shfl_xor(v2, st);
                const int k0 = __shfl_xor(i0, st), k1 = __shfl_xor(i1, st), k2 = __shfl_xor(i2, st);
                sel_insert(w0, k0, v0, i0, v1, i1, v2, i2); sel_insert(w1, k1, v0, i0, v1, i1, v2, i2); sel_insert(w2, k2, v0, i0, v1, i1, v2, i2);
            }
            const int nsel = j < 3 ? j : 3;
            const int mine = (fq == 0) ? i0 : (fq == 1) ? i1 : i2;
            selv[gi] = (fq < nsel) ? mine : -1; lpv[gi] = 0u;
            if (selv[gi] >= 0) lpv[gi] = lds_add(lcnt + selv[gi], 1u);
        }
        __syncthreads();
        if (tid_ < 64) { const unsigned cc = lcnt[tid_]; lbase[tid_] = cc ? atomicAdd(LCNT + (b * NH + h) * NBLK + tid_, cc) : 0u; }
        __syncthreads();
        { unsigned short* lb = LIST + (size_t)((b * NH + h) * NBLK) * SEQ;
#pragma unroll
          for (int gi = 0; gi < 4; ++gi) if (selv[gi] >= 0) { const int s = c * 512 + (wave_ * 4 + gi) * 16 + fr;
              lb[(size_t)selv[gi] * SEQ + lbase[selv[gi]] + lpv[gi]] = (unsigned short)((s << 2) | fq); } }
        __syncthreads();
    }
}

#define MFMA32(a, b, c) __builtin_amdgcn_mfma_f32_32x32x16_bf16((a), (b), (c), 0, 0, 0)
DI bf16x8 pack8(const f32x16& x, int s) {
    u32x4 p; p.x = pk2(x[8 * s], x[8 * s + 1]); p.y = pk2(x[8 * s + 2], x[8 * s + 3]); p.z = pk2(x[8 * s + 4], x[8 * s + 5]); p.w = pk2(x[8 * s + 6], x[8 * s + 7]);
    return __builtin_bit_cast(bf16x8, p);
}
DI void moba_partial(const Frame& F) {
    unsigned char* ws = F.ws;
    const unsigned char* Q8 = ws + O_Q8; const unsigned char* K8 = ws + O_K8; const unsigned char* VT8 = ws + O_VT8;
    const unsigned* LCNT = (const unsigned*)(ws + ZO_LCNT); const unsigned short* LIST0 = (const unsigned short*)(ws + O_LIST);
    unsigned char* PO = ws + O_PO; f32x2* ML = (f32x2*)(ws + O_ML);
    unsigned* qctr = (unsigned*)(ws + ZO_CNT) + 128;
    LAS int* pre = (LAS int*)(F.lds + TAB_OFF);
    LAS int* qslot = (LAS int*)(F.lds + MISC_OFF + 64);
    int wvv = F.wv; asm volatile("" : "+s"(wvv)); int tid = wvv * 64 + lane_id(); asm volatile("" : "+v"(tid));
    const int w = F.wv;
    int cur = 0;
#pragma unroll
    for (int q = 0; q < 2; ++q) { const int io = tid + 512 * q, bh = io & 15, nq = io >> 4; const int cnt = (int)LCNT[bh * NBLK + nq]; const int tiles = 1 + ((cnt + 255) >> 8); pre[io] = (tiles + ATT_C - 1) / ATT_C; }
    __syncthreads();
    for (int off = 1; off < 1024; off <<= 1) {
        int v[2];
#pragma unroll
        for (int q = 0; q < 2; ++q) { const int io = tid + 512 * q; v[q] = pre[cur * 1024 + io] + (io >= off ? pre[cur * 1024 + io - off] : 0); }
#pragma unroll
        for (int q = 0; q < 2; ++q) pre[(cur ^ 1) * 1024 + tid + 512 * q] = v[q];
        __syncthreads(); cur ^= 1; }
    const LAS int* pf = pre + cur * 1024;
    const int U = __builtin_amdgcn_readfirstlane(pf[1023]);
    for (;;) {
        if (tid == 0) *qslot = (int)__hip_atomic_fetch_add(qctr, 1u, __ATOMIC_RELAXED, __HIP_MEMORY_SCOPE_AGENT);
        __syncthreads();
        const int u = __builtin_amdgcn_readfirstlane(*qslot);
        if (u >= U) break;
        int lo = 0, hi = 1023;
        while (lo < hi) { const int mid = (lo + hi) >> 1; if (pf[mid] > u) hi = mid; else lo = mid + 1; }
        const int io = lo, chunk = u - (io ? pf[io - 1] : 0);
        const int h = io & 7, b = (io >> 3) & 1, n = io >> 4, item = (b * NH + h) * NBLK + n;
        const unsigned short* LIST = LIST0;
        const int cnt = (int)LCNT[item];
        const int ntile = 1 + ((cnt + 255) >> 8);
        const int tile0 = chunk * ATT_C, tile1 = (tile0 + ATT_C < ntile) ? tile0 + ATT_C : ntile;
        const size_t tbase = (size_t)b * SEQ + n * 256;
        asm volatile("" : "+v"(tid));
        const int lane = tid & 63, r = lane & 31, hh = lane >> 5;
        const int qi = 32 * w + r;
#pragma unroll
        for (int i = 0; i < 4; ++i) { const int p = tid + 512 * i, key = p >> 3, c = p & 7;
            const u32x4 v = *(const u32x4*)(K8 + (tbase + key) * D + h * HD + c * 16);
            *(LAS u32x4*)(F.lds + key * 128 + ((c ^ ((key >> 1) & 7)) << 4)) = v; }
#pragma unroll
        for (int i = 0; i < 4; ++i) { const int p = tid + 512 * i, d = p >> 4, j16 = p & 15, G = j16 >> 2, j = j16 & 3;
            const u32x4 v = *(const u32x4*)(VT8 + (size_t)(h * HD + d) * T + tbase + j16 * 16);
            const int pos0 = (j >> 1) * 16 + (j & 1) * 8;
            const int bo0 = G * 64 + pos0, bo1 = bo0 + 32;
            *(LAS u32x2*)(F.lds + 32768 + d * 256 + ((((bo0 >> 4) ^ (d & 15)) << 4) | (bo0 & 15))) = (u32x2){v.x, v.z};
            *(LAS u32x2*)(F.lds + 32768 + d * 256 + ((((bo1 >> 4) ^ (d & 15)) << 4) | (bo1 & 15))) = (u32x2){v.y, v.w}; }
        __syncthreads();
#define MFMA8Z(acc_, a_, b_) asm volatile("v_mfma_scale_f32_32x32x64_f8f6f4 %0, %1, %2, 0, %3, %3 op_sel_hi:[0,0,0]" : "=&v"(acc_) : "v"(a_), "v"(b_), "v"(one_e8m0))
#define MFMA8(acc_, a_, b_) asm volatile("v_mfma_scale_f32_32x32x64_f8f6f4 %0, %1, %2, %0, %3, %3 op_sel_hi:[0,0,0]" : "+v"(acc_) : "v"(a_), "v"(b_), "v"(one_e8m0))
#define MFMA_SETTLE() asm volatile("s_nop 7\n\ts_nop 7\n\ts_nop 7" ::: "memory")
        const int one_e8m0 = 0x7F7F7F7F;
#pragma unroll 1
        for (int tile = tile0; tile < tile1; ++tile) {
        bool valid; int sl, rr;
        if (tile == 0) { sl = n * 256 + qi; rr = 3; valid = true; }
        else { const int idx = (tile - 1) * 256 + qi; valid = idx < cnt; const int e = valid ? (int)LIST[(size_t)item * SEQ + idx] : 0; sl = e >> 2; rr = e & 3; }
        (void)rr; (void)valid;
        const bool wave_active = (tile == 0) || ((tile - 1) * 256 + 32 * w < cnt);
        if (wave_active) {
            i32x8 qf[2];
            { const unsigned char* qp = Q8 + ((size_t)b * SEQ + sl) * D + h * HD + 32 * hh;
#pragma unroll
              for (int mf = 0; mf < 2; ++mf) qf[mf] = __builtin_shufflevector(*(const i32x4*)(qp + 64 * mf), *(const i32x4*)(qp + 64 * mf + 16), 0, 1, 2, 3, 4, 5, 6, 7); }
            f32x16 o[4];
            float mrun = -__builtin_inff(), lrun = 0.f;
            const float sc = 0.08838834764831845f * 1.4426950408889634f * (1.0f / (S8_QK * S8_QK));
            const int nhalf = (tile == 0 && w < 4) ? 1 : 2;
            const int rq0 = (r >> 3) & 3, rl0 = r & 7;
#pragma unroll 1
            for (int hf = 0; hf < nhalf; ++hf) {
                int rl = rl0, rq = rq0; asm volatile("" : "+v"(rl), "+v"(rq));
                const int rr_ = (rq << 3) | rl;
                f32x16 x[4];
                {
                    const int ksw = (rr_ >> 1) & 7;
                    const LAS unsigned char* kl = F.lds + hf * 16384 + rr_ * 128;
#pragma unroll
                    for (int mf = 0; mf < 2; ++mf)
#pragma unroll
                        for (int kt = 0; kt < 4; ++kt) {
                            const i32x4 k0 = *(const LAS i32x4*)(kl + kt * 4096 + (((4 * mf + 2 * hh) ^ ksw) << 4)), k1 = *(const LAS i32x4*)(kl + kt * 4096 + (((4 * mf + 2 * hh + 1) ^ ksw) << 4));
                            const i32x8 kf = __builtin_shufflevector(k0, k1, 0, 1, 2, 3, 4, 5, 6, 7);
                            if (mf == 0) MFMA8Z(x[kt], kf, qf[0]); else MFMA8(x[kt], kf, qf[1]);
                        }
                    MFMA_SETTLE();
                }
                __builtin_amdgcn_sched_barrier(0);
                if (tile == 0) {
                    const int thr = rr_ - 4 * hh;
#pragma unroll
                    for (int kt = 0; kt < 4; ++kt) {
                        const int kd = 4 * hf + kt - w;
                        if (kd > 0) { asm volatile("" ::: "memory");
#pragma unroll
                            for (int i = 0; i < 16; ++i) x[kt][i] = -__builtin_inff(); }
                        else if (kd == 0) { asm volatile("" ::: "memory");
#pragma unroll
                            for (int i = 0; i < 16; ++i) if ((i & 3) + 8 * (i >> 2) > thr) x[kt][i] = -__builtin_inff(); }
                    }
                }
                float mx = mrun;
#pragma unroll
                for (int kt = 0; kt < 4; ++kt)
#pragma unroll
                    for (int i = 0; i < 16; ++i) mx = fmaxf(mx, x[kt][i]);
                mx = fmaxf(mx, __shfl_xor(mx, 32));
                const float mxs = mx * sc - 8.0f;
                const float resc = (hf > 0) ? fexp2((mrun - mx) * sc) : 0.f;
                lrun *= resc;
                if (hf > 0) {
#pragma unroll
                    for (int dt = 0; dt < 4; ++dt)
#pragma unroll
                        for (int i = 0; i < 16; ++i) o[dt][i] *= resc;
                }
                mrun = mx;
                float l = 0.f;
                const LAS unsigned char* vl = F.lds + 32768 + rr_ * 256;
#pragma unroll
                for (int kp = 0; kp < 2; ++kp) {
                    float pv[32];
#pragma unroll
                    for (int a2 = 0; a2 < 2; ++a2)
#pragma unroll
                        for (int i = 0; i < 16; ++i) { const float p = fexp2(__builtin_fmaf(x[2 * kp + a2][i], sc, -mxs)); l += p; pv[a2 * 16 + i] = p; }
                    i32x8 pf;
#pragma unroll
                    for (int q4 = 0; q4 < 8; ++q4) { int wv = 0; wv = __builtin_amdgcn_cvt_pk_fp8_f32(pv[4 * q4], pv[4 * q4 + 1], wv, false); wv = __builtin_amdgcn_cvt_pk_fp8_f32(pv[4 * q4 + 2], pv[4 * q4 + 3], wv, true); pf[q4] = wv; }
                    asm volatile("s_nop 3" ::: "memory");
                    const int c0 = 4 * (2 * hf + kp) + 2 * hh;
#pragma unroll
                    for (int dt = 0; dt < 4; ++dt) {
                        const i32x4 v0 = *(const LAS i32x4*)(vl + dt * 8192 + ((c0 ^ (rr_ & 15)) << 4)), v1 = *(const LAS i32x4*)(vl + dt * 8192 + (((c0 + 1) ^ (rr_ & 15)) << 4));
                        const i32x8 vf = __builtin_shufflevector(v0, v1, 0, 1, 2, 3, 4, 5, 6, 7);
                        if (hf == 0 && kp == 0) MFMA8Z(o[dt], vf, pf); else MFMA8(o[dt], vf, pf);
                    }
                    __builtin_amdgcn_sched_barrier(0);
                }
                MFMA_SETTLE();
                l += __shfl_xor(l, 32);
                lrun += l;
                __builtin_amdgcn_sched_barrier(0);
            }
            bool valid2; int sl2, rr2;
            int tl2 = tid; asm volatile("" : "+v"(tl2)); const int ln2 = tl2 & 31, hh2 = (tl2 >> 5) & 1, qi2 = 32 * w + ln2;
            if (tile == 0) { sl2 = n * 256 + qi2; rr2 = 3; valid2 = true; }
            else { const int idx = (tile - 1) * 256 + qi2; valid2 = idx < cnt; const int e = valid2 ? (int)LIST[(size_t)item * SEQ + idx] : 0; sl2 = e >> 2; rr2 = e & 3; }
            if (valid2) {
                const float inv = frcp(lrun);
                const size_t pair = ((size_t)(b * SEQ + sl2) * NH + h) * 4 + rr2;
                unsigned char* po = PO + pair * HD;
                const float is8 = inv * (S8_PO / S8_V);
#pragma unroll
                for (int dt = 0; dt < 4; ++dt)
#pragma unroll
                    for (int g4 = 0; g4 < 4; ++g4)
                        *(unsigned*)(po + 32 * dt + 8 * g4 + 4 * hh2) = pk4_fp8(o[dt][4 * g4] * is8, o[dt][4 * g4 + 1] * is8, o[dt][4 * g4 + 2] * is8, o[dt][4 * g4 + 3] * is8);
                if (hh2 == 0) ML[pair] = (f32x2){mrun * sc, lrun * (1.0f / S8_P)};
            }
        }
        }
#undef MFMA8Z
#undef MFMA8
#undef MFMA_SETTLE
        __syncthreads();
    }
}

DI void moba_combine(const Frame& F) {
    PHASE_IDS;
    unsigned char* ws = F.ws;
    const unsigned char* PO = ws + O_PO; const f32x2* ML = (const f32x2*)(ws + O_ML);
    bf16_t* AO = (bf16_t*)(ws + O_Q);
    for (int it = blockIdx.x * 512 + tid_; it < T * 64; it += F.G * 512) {
        const int t = it >> 6, h = (it >> 3) & 7, dp = it & 7, sq = t & (SEQ - 1);
        const int nv = (sq >> 8) < 3 ? (sq >> 8) : 3;
        const size_t base = ((size_t)t * NH + h) * 4;
        f32x2 ml[4]; float ms = -3.0e38f;
#pragma unroll
        for (int r = 0; r < 4; ++r) { const bool ok = (r == 3) || (r < nv); ml[r] = ok ? ML[base + r] : (f32x2){-3.0e38f, 0.f}; ms = fmaxf(ms, ml[r][0]); }
        float wsum = 0.f; float wr[4];
#pragma unroll
        for (int r = 0; r < 4; ++r) { const bool ok = (r == 3) || (r < nv); wr[r] = ok ? ml[r][1] * fexp2(ml[r][0] - ms) : 0.f; wsum += wr[r]; }
        float acc[16];
#pragma unroll
        for (int i = 0; i < 16; ++i) acc[i] = 0.f;
#pragma unroll
        for (int r = 0; r < 4; ++r) {
            const bool ok = (r == 3) || (r < nv);
            if (ok) {
                const u32x4 a = *(const u32x4*)(PO + (base + r) * HD + dp * 16);
                const float wv = wr[r];
                const unsigned wd[4] = {a.x, a.y, a.z, a.w};
#pragma unroll
                for (int q = 0; q < 4; ++q) { const f32x2 lo2 = __builtin_amdgcn_cvt_pk_f32_fp8((int)wd[q], false), hi2 = __builtin_amdgcn_cvt_pk_f32_fp8((int)wd[q], true);
                    acc[4 * q] += wv * lo2.x; acc[4 * q + 1] += wv * lo2.y; acc[4 * q + 2] += wv * hi2.x; acc[4 * q + 3] += wv * hi2.y; }
            }
        }
        const float inv = frcp(wsum) * (1.0f / S8_PO);
        u32x4 o0, o1;
        o0.x = pk2(acc[0] * inv, acc[1] * inv); o0.y = pk2(acc[2] * inv, acc[3] * inv); o0.z = pk2(acc[4] * inv, acc[5] * inv); o0.w = pk2(acc[6] * inv, acc[7] * inv);
        o1.x = pk2(acc[8] * inv, acc[9] * inv); o1.y = pk2(acc[10] * inv, acc[11] * inv); o1.z = pk2(acc[12] * inv, acc[13] * inv); o1.w = pk2(acc[14] * inv, acc[15] * inv);
        bf16_t* op = AO + (size_t)t * D + h * HD + dp * 16;
        *(u32x4*)op = o0; *(u32x4*)(op + 8) = o1;
    }
}

#if SELFCHECK
DI void sc_sample(int i, int& b, int& sq, int& h) {
    const int special[12] = {0, 1, 255, 256, 257, 511, 512, 767, 768, 1023, 16383, 8191};
    b = i & 1; h = (i >> 1) & 7; const int k = i >> 4;
    sq = (k < 12) ? special[k] : (int)(((unsigned)(k * 7919 + i * 104729 + 12345)) % SEQ);
}
DI void attn_selfcheck_ref(const Frame& F) {
    PHASE_IDS;
    unsigned char* ws = F.ws;
    const bf16_t* Q = (const bf16_t*)(ws + O_Q); const unsigned char* Q8 = ws + O_Q8; const unsigned char* K8 = ws + O_K8; const unsigned char* VT8 = ws + O_VT8; const float* KM = (const float*)(ws + ZO_KM);
#define F8DEC(byte_) __builtin_amdgcn_cvt_f32_fp8((int)(unsigned)(byte_), 0)
    float* ref = (float*)(ws + WS_TOP);
    LAS float* ql = (LAS float*)F.lds; LAS float* gl = ql + 128; LAS float* pl = gl + 64; LAS float* red = pl + 1024; LAS int* sel = (LAS int*)(red + 16); LAS float* part = red + 32; LAS float* q8l = part + 512;
    for (int smp = blockIdx.x; smp < 512; smp += F.G) {
        int b, sq, h; sc_sample(smp, b, sq, h);
        const int j = sq >> 8;
        if (tid_ < 128) { const unsigned short v = Q[((size_t)(b * SEQ + sq)) * D + h * HD + tid_]; ql[tid_] = __uint_as_float((unsigned)v << 16); q8l[tid_] = F8DEC(Q8[((size_t)(b * SEQ + sq)) * D + h * HD + tid_]); }
        __syncthreads();
        if (tid_ < 64) { float g = -3.0e38f;
            if (tid_ < j) { float d0 = 0.f, d1 = 0.f, d2 = 0.f, d3 = 0.f; const float* kp = KM + (size_t)((b * NH + h) * NBLK + tid_) * HD;
                for (int d4 = 0; d4 < 32; ++d4) { d0 += ql[d4 * 4] * (kp[d4 * 4] * (1.0f / 256.0f)); d1 += ql[d4 * 4 + 1] * (kp[d4 * 4 + 1] * (1.0f / 256.0f)); d2 += ql[d4 * 4 + 2] * (kp[d4 * 4 + 2] * (1.0f / 256.0f)); d3 += ql[d4 * 4 + 3] * (kp[d4 * 4 + 3] * (1.0f / 256.0f)); }
                g = (d0 + d1) + (d2 + d3); }
            gl[tid_] = g; }
        __syncthreads();
        if (tid_ == 0) { float v0 = -3.0e38f, v1 = -3.0e38f, v2 = -3.0e38f; int i0 = 0, i1 = 0, i2 = 0;
            for (int n = 0; n < j; ++n) { const float g = gl[n];
                if (g > v0) { v2 = v1; i2 = i1; v1 = v0; i1 = i0; v0 = g; i0 = n; } else if (g > v1) { v2 = v1; i2 = i1; v1 = g; i1 = n; } else if (g > v2) { v2 = g; i2 = n; } }
            const int ns = j < 3 ? j : 3; sel[0] = ns > 0 ? i0 : -1; sel[1] = ns > 1 ? i1 : -1; sel[2] = ns > 2 ? i2 : -1; sel[3] = j; }
        __syncthreads();
        float mloc = -3.0e38f;
        for (int slot = tid_; slot < 1024; slot += 512) { const int bi = slot >> 8, key = slot & 255, blk = sel[bi]; float sc = -3.0e38f;
            if (blk >= 0 && (bi < 3 || blk * 256 + key <= sq)) { const unsigned char* kp = K8 + ((size_t)(b * SEQ + blk * 256 + key)) * D + h * HD; float a = 0.f;
                for (int d = 0; d < HD; ++d) a += q8l[d] * F8DEC(kp[d]);
                sc = a * (0.08838834764831845f / (S8_QK * S8_QK)); }
            pl[slot] = sc; mloc = fmaxf(mloc, sc); }
        mloc = fmaxf(mloc, __shfl_xor(mloc, 32)); mloc = fmaxf(mloc, __shfl_xor(mloc, 16)); mloc = fmaxf(mloc, __shfl_xor(mloc, 8)); mloc = fmaxf(mloc, __shfl_xor(mloc, 4)); mloc = fmaxf(mloc, __shfl_xor(mloc, 2)); mloc = fmaxf(mloc, __shfl_xor(mloc, 1));
        if (lane_ == 0) red[wave_] = mloc;
        __syncthreads();
        float mx = red[0]; for (int w = 1; w < 8; ++w) mx = fmaxf(mx, red[w]);
        __syncthreads();
        float sloc = 0.f;
        for (int slot = tid_; slot < 1024; slot += 512) { const float sc = pl[slot]; const float p = (sc > -1.0e38f) ? fexp2((sc - mx) * 1.4426950408889634f) : 0.f; pl[slot] = p; sloc += p; }
        sloc = wave_sum(sloc);
        if (lane_ == 0) red[wave_] = sloc;
        __syncthreads();
        float ssum = 0.f; for (int w = 0; w < 8; ++w) ssum += red[w];
        { const int d = tid_ & 127, bi = tid_ >> 7, blk = sel[bi]; float a = 0.f;
          if (blk >= 0) { const unsigned char* vp = VT8 + (size_t)(h * HD + d) * T + (size_t)b * SEQ + blk * 256;
              for (int key = 0; key < 256; ++key) a += pl[bi * 256 + key] * (F8DEC(vp[key]) * (1.0f / S8_V)); }
          part[tid_] = a; }
        __syncthreads();
        if (tid_ < 128) ref[(size_t)smp * 128 + tid_] = ((part[tid_] + part[128 + tid_]) + (part[256 + tid_] + part[384 + tid_])) / ssum;
        __syncthreads();
    }
#undef F8DEC
}
DI void attn_selfcheck_cmp(const Frame& F) {
    PHASE_IDS;
    unsigned char* ws = F.ws;
    const bf16_t* AO = (const bf16_t*)(ws + O_Q); const float* ref = (const float*)(ws + WS_TOP); unsigned* flag = (unsigned*)(ws + ZO_CNT) + 320;
    LAS float* red = (LAS float*)F.lds;
    for (int smp = blockIdx.x; smp < 512; smp += F.G) {
        int b, sq, h; sc_sample(smp, b, sq, h);
        float r = 0.f, a = 0.f;
        if (tid_ < 128) { r = ref[(size_t)smp * 128 + tid_]; a = __uint_as_float((unsigned)AO[((size_t)(b * SEQ + sq)) * D + h * HD + tid_] << 16); }
        float mr = fabsf(r); mr = fmaxf(mr, __shfl_xor(mr, 32)); mr = fmaxf(mr, __shfl_xor(mr, 16)); mr = fmaxf(mr, __shfl_xor(mr, 8)); mr = fmaxf(mr, __shfl_xor(mr, 4)); mr = fmaxf(mr, __shfl_xor(mr, 2)); mr = fmaxf(mr, __shfl_xor(mr, 1));
        if (lane_ == 0) red[wave_] = mr;
        __syncthreads();
        const float mx = fmaxf(red[0], red[1]);
        const bool bad = (tid_ < 128) && !(fabsf(a - r) <= SELFCHECK_TOL * mx + 0.001f);
        if (bad) __hip_atomic_store(flag, 1u, __ATOMIC_RELAXED, __HIP_MEMORY_SCOPE_AGENT);
        __syncthreads();
    }
}
#endif

DI void moe_router(const Frame& F) {
    PHASE_IDS;
    unsigned char* ws = F.ws;
    const bf16_t* H = (const bf16_t*)(ws + O_H4B); const float* rw = inp(I_ROUTER); const float* gn = inp(I_FFN_NORM) + D;
    LAS bf16_t* wh = (LAS bf16_t*)F.lds;
    LAS bf16_t* wl = wh + 32 * 16 * 40;
    LAS unsigned* lcnt = (LAS unsigned*)(F.lds + 98304);
    for (int i = tid_; i < 32 * 16 * 32; i += 512) {
        const int kk = i & 31, e = (i >> 5) & 15, ks = i >> 9, k = ks * 32 + kk;
        float w = 0.f; if (e < NE) w = rw[k * NE + e] * gn[k];
        const unsigned hi = pk2(w, 0.f) & 0xffffu; const float wr = w - __uint_as_float(hi << 16);
        wh[(ks * 16 + e) * 40 + kk] = (bf16_t)hi; wl[(ks * 16 + e) * 40 + kk] = (bf16_t)(pk2(wr, 0.f) & 0xffffu);
    }
    if (tid_ < 8) lcnt[tid_] = 0u;
    __syncthreads();
    unsigned* top = (unsigned*)(ws + WS_TOP);
    const int fr = lane_ & 15, fq = lane_ >> 4;
    for (int r0 = (blockIdx.x * 8 + wave_) * 16; r0 < T; r0 += F.G * 128) {
        const bf16_t* hp = H + (size_t)(r0 + fr) * D + 8 * fq;
        bf16x8 av[32];
#pragma unroll
        for (int ks = 0; ks < 32; ++ks) av[ks] = *(const bf16x8*)(hp + ks * 32);
        f32x4 acc = {0.f, 0.f, 0.f, 0.f}; float ss = 0.f;
#pragma unroll
        for (int ks = 0; ks < 32; ++ks) {
            const bf16x8 bh = *(const LAS bf16x8*)(wh + (ks * 16 + fr) * 40 + 8 * fq), bl = *(const LAS bf16x8*)(wl + (ks * 16 + fr) * 40 + 8 * fq);
            acc = __builtin_amdgcn_mfma_f32_16x16x32_bf16(bh, av[ks], acc, 0, 0, 0);
            acc = __builtin_amdgcn_mfma_f32_16x16x32_bf16(bl, av[ks], acc, 0, 0, 0);
#pragma unroll
            for (int j = 0; j < 8; ++j) { const float v = __uint_as_float((unsigned)(unsigned short)av[ks][j] << 16); ss += v * v; }
        }
        ss += __shfl_xor(ss, 16); ss += __shfl_xor(ss, 32);
        float lg[8];
#pragma unroll
        for (int j = 0; j < 4; ++j) { const float o = __shfl_xor(acc[j], 16); lg[j] = acc[j]; lg[4 + j] = o; }
        if (fq == 0) {
            const int row = r0 + fr;
            const float rstd = __builtin_amdgcn_rsqf(ss * (1.0f / D) + EPS);
            int e1 = 0; float b1 = lg[0];
#pragma unroll
            for (int e = 1; e < 8; ++e) if (lg[e] > b1) { b1 = lg[e]; e1 = e; }
            int e2 = -1; float b2 = -3.0e38f;
#pragma unroll
            for (int e = 0; e < 8; ++e) if (e != e1 && lg[e] > b2) { b2 = lg[e]; e2 = e; }
            const float w1 = frcp(1.0f + fexp2((b2 - b1) * rstd * 1.4426950408889634f)), w2 = 1.0f - w1;
            unsigned* tp = top + (size_t)row * 8;
            tp[0] = (unsigned)e1; tp[1] = (unsigned)e2; tp[2] = __float_as_uint(w1); tp[3] = __float_as_uint(w2); tp[4] = __float_as_uint(rstd);
            lds_add(lcnt + e1, 1u); lds_add(lcnt + e2, 1u);
        }
    }
    __syncthreads();
    if (tid_ < 8) atomicAdd((unsigned*)(ws + ZO_CNT) + tid_, lcnt[tid_]);
}

DI void moe_slots(const Frame& F) {
    PHASE_IDS;
    unsigned char* ws = F.ws;
    const unsigned* CNT = (const unsigned*)(ws + ZO_CNT); unsigned* CNT2 = (unsigned*)(ws + ZO_CNT) + 64;
    const unsigned* top = (const unsigned*)(ws + WS_TOP);
    int* slot_tok = (int*)(ws + WS_SLOT); float* slot_rstd = (float*)(ws + WS_SLOT + 512 * KiB); float* slot_gate = (float*)(ws + WS_SLOT + 1024 * KiB); int* slot_dst = (int*)(ws + WS_SLOT + 1536 * KiB);
    LAS unsigned* lc = (LAS unsigned*)F.lds; LAS unsigned* gb = lc + 8; LAS unsigned* sb = lc + 16; LAS unsigned* cn = lc + 32;
    if (tid_ == 0) { unsigned a = 0; for (int e = 0; e < 8; ++e) { const unsigned c = CNT[e]; cn[e] = c; sb[e] = a; a += ((c + 255u) >> 8) << 8; } sb[8] = a; }
    if (tid_ < 8) lc[tid_] = 0u;
    __syncthreads();
    for (int chunk = blockIdx.x; chunk < T / 128; chunk += F.G) {
        int e = 0, tok = 0, k = 0; unsigned lpos = 0;
        if (tid_ < 256) { tok = chunk * 128 + (tid_ >> 1); k = tid_ & 1; e = (int)top[(size_t)tok * 8 + k]; lpos = lds_add(lc + e, 1u); }
        __syncthreads();
        if (tid_ < 8) gb[tid_] = sb[tid_] + atomicAdd(CNT2 + tid_, lc[tid_]);
        __syncthreads();
        if (tid_ < 256) {
            const unsigned slot = gb[e] + lpos;
            slot_tok[slot] = tok; slot_rstd[slot] = __uint_as_float(top[(size_t)tok * 8 + 4]); slot_gate[slot] = __uint_as_float(top[(size_t)tok * 8 + 2 + k]); slot_dst[slot] = tok * 2 + k;
        }
        __syncthreads();
        if (tid_ < 8) lc[tid_] = 0u;
        __syncthreads();
    }
    if (blockIdx.x == 0) {
        for (int e = 0; e < 8; ++e)
            for (unsigned sl = sb[e] + cn[e] + tid_; sl < sb[e + 1]; sl += 512) { slot_tok[sl] = 0; slot_rstd[sl] = 0.f; slot_gate[sl] = 0.f; slot_dst[sl] = -1; }
    }
}

DI void moe_combine(const Frame& F) {
    PHASE_IDS;
    unsigned char* ws = F.ws;
    bf16_t* H = (bf16_t*)(ws + O_H5B); const bf16_t* Y1 = (const bf16_t*)(ws + O_Y1); const bf16_t* Y2 = (const bf16_t*)(ws + O_Y2); float* SQ = (float*)(ws + ZO_SQ5);
    for (int row0 = (blockIdx.x * 8 + wave_) * 4; row0 < T; row0 += F.G * 32) {
        u32x4 hw[4][2], aw[4][2], cw[4][2];
#pragma unroll
        for (int q = 0; q < 4; ++q)
#pragma unroll
            for (int j = 0; j < 2; ++j) { const size_t base = (size_t)(row0 + q) * D + j * 512 + lane_ * 8; hw[q][j] = *(const u32x4*)(H + base); aw[q][j] = *(const u32x4*)(Y1 + base); cw[q][j] = *(const u32x4*)(Y2 + base); }
#pragma unroll
        for (int q = 0; q < 4; ++q) {
            float ss = 0.f;
#pragma unroll
            for (int j = 0; j < 2; ++j) {
                const u32x4 h = hw[q][j], a = aw[q][j], c = cw[q][j]; float v[8];
                v[0] = bf_lo(h.x) + (bf_lo(a.x) + bf_lo(c.x)); v[1] = bf_hi(h.x) + (bf_hi(a.x) + bf_hi(c.x)); v[2] = bf_lo(h.y) + (bf_lo(a.y) + bf_lo(c.y)); v[3] = bf_hi(h.y) + (bf_hi(a.y) + bf_hi(c.y));
                v[4] = bf_lo(h.z) + (bf_lo(a.z) + bf_lo(c.z)); v[5] = bf_hi(h.z) + (bf_hi(a.z) + bf_hi(c.z)); v[6] = bf_lo(h.w) + (bf_lo(a.w) + bf_lo(c.w)); v[7] = bf_hi(h.w) + (bf_hi(a.w) + bf_hi(c.w));
                u32x4 w; w.x = pk2(v[0], v[1]); w.y = pk2(v[2], v[3]); w.z = pk2(v[4], v[5]); w.w = pk2(v[6], v[7]);
                *(u32x4*)(H + (size_t)(row0 + q) * D + j * 512 + lane_ * 8) = w;
#pragma unroll
                for (int e = 0; e < 8; ++e) ss += v[e] * v[e];
            }
            ss = wave_sum(ss);
            if (lane_ == 0) *(f32x4*)(SQ + (size_t)(row0 + q) * 4) = (f32x4){ss, 0.f, 0.f, 0.f};
        }
    }
}

DI void final_norm(const Frame& F) {
    PHASE_IDS;
    const bf16_t* H = (const bf16_t*)(F.ws + O_H6B); float* out = F.out; const float* SQ = (const float*)(F.ws + ZO_SQ6); const float* g = inp(I_FINAL_NORM);
    f32x4 gv[2][2];
#pragma unroll
    for (int j = 0; j < 2; ++j) { gv[j][0] = *(const f32x4*)(g + j * 512 + lane_ * 8); gv[j][1] = *(const f32x4*)(g + j * 512 + lane_ * 8 + 4); }
#if SELFCHECK
    const float poison = (__hip_atomic_load((unsigned*)(F.ws + ZO_CNT) + 320, __ATOMIC_RELAXED, __HIP_MEMORY_SCOPE_AGENT) != 0u) ? __builtin_nanf("") : 0.f;
#else
    const float poison = 0.f;
#endif
    for (int row0 = (blockIdx.x * 8 + wave_) * 4; row0 < T; row0 += F.G * 32) {
        u32x4 hw[4][2]; float rv[4];
#pragma unroll
        for (int q = 0; q < 4; ++q) { const size_t base = (size_t)(row0 + q) * D + lane_ * 8; hw[q][0] = *(const u32x4*)(H + base); hw[q][1] = *(const u32x4*)(H + base + 512); rv[q] = pg8::sq_rstd(SQ, row0 + q); }
#pragma unroll
        for (int q = 0; q < 4; ++q)
#pragma unroll
            for (int j = 0; j < 2; ++j) { const u32x4 w = hw[q][j]; float* op = out + (size_t)(row0 + q) * D + j * 512 + lane_ * 8;
                *(f32x4*)op = (f32x4){bf_lo(w.x), bf_hi(w.x), bf_lo(w.y), bf_hi(w.y)} * rv[q] * gv[j][0] + poison;
                *(f32x4*)(op + 4) = (f32x4){bf_lo(w.z), bf_hi(w.z), bf_lo(w.w), bf_hi(w.w)} * rv[q] * gv[j][1]; }
    }
}

constexpr int NPH = 21;
__global__ void __launch_bounds__(512, 2) fwd_kernel(Args args) {
    extern __shared__ __attribute__((aligned(16))) unsigned char lds_raw[];
    Frame F;
    F.lds = (LAS unsigned char*)lds_raw;
    F.G = gridDim.x; { int wv = __builtin_amdgcn_readfirstlane((int)threadIdx.x >> 6); asm volatile("" : "+s"(wv)); F.wv = wv; }
    F.out = args.out; F.ws = args.ws;
    unsigned char* ws = args.ws;
    for (int u = threadIdx.x; u < (LDS_BYTES - LDSCTL_OFF) / 4; u += 512) ((LAS unsigned*)(F.lds + LDSCTL_OFF))[u] = 0u;
    __syncthreads();
    volatile LAS unsigned* MISC = (volatile LAS unsigned*)(F.lds + MISC_OFF);
    XcdBarrier bar; bar.bar = (unsigned*)(ws + ZO_BAR); bar.x = 0; bar.st = nullptr;
    if (MK_N_LAUNCHES == 1) bar = xcd_barrier_post((unsigned*)(ws + ZO_BAR), MISC + 8, threadIdx.x == 0);
    const int lo = args.ph_lo, hi = args.ph_hi;
#ifdef ONLY_PH
#define IN(k) ((k) == ONLY_PH && lo <= (k) && (k) < hi)
#else
#define IN(k) (lo <= (k) && (k) < hi)
#endif
#define SEAM(k) do { if (IN(k) && IN((k) + 1)) { xcd_barrier(bar, F.wv == 0 && lane_id() == 0); } } while (0)
    LAS unsigned char* ring = F.lds;
    LAS float* part = (LAS float*)(F.lds + TAB_OFF);
    const int G = F.G, cid = (int)blockIdx.x;
    using namespace pg8;

    if (IN(0)) { for (int rep = 0; rep < DUPN(1); ++rep) p0_prologue(F); } SEAM(0);

    if (IN(1)) {
        if (I8_UP) { int rot = 0;
            conv_matrix_fp8(F, inp(I_W1), D, FF, ws + WO_F13, 0, 1, inp(I_FFN_NORM), 1.f, rot, (const float*)(ws + ZO_WMAX));
            conv_matrix_fp8(F, inp(I_W3), D, FF, ws + WO_F13, 0, 2, inp(I_FFN_NORM), 1.f, rot, (const float*)(ws + ZO_WMAX) + FF);
            if (I8_QKV) {
                conv_matrix_fp8(F, inp(I_WQ), D, D, ws + WO_QK, 0, 0, inp(I_ATTN_NORM), 1.f, rot, (const float*)(ws + ZO_WMQKV));
                conv_matrix_fp8(F, inp(I_WK), D, D, ws + WO_QK, D, 0, inp(I_KV_NORM), 1.f, rot, (const float*)(ws + ZO_WMQKV) + D);
                conv_matrix_fp8(F, inp(I_WV), D, D, ws + WO_V, 0, 0, inp(I_KV_NORM), 1.f, rot, (const float*)(ws + ZO_WMQKV) + 2 * D); } }
        { Gemm g{(const bf16_t*)(ws + O_POOLED), (const bf16_t*)(ws + WO_POOL), 256, nullptr, F.wv}; OrdPool S; S.init(T / 256, 4, G, cid);
          EpiResid<false> E{inp(I_X), (bf16_t*)(ws + O_H1B), (float*)(ws + ZO_SQ1), part, (FP8_FFN0 & 1) ? ws + O_H1F8 : nullptr, I8_UP ? ws + O_H1I8 : nullptr, 1.f};
          gemm_phase<EpiResid<false>, OrdPool, false>(ring, g, S, E); }
        { Gemm g{(const bf16_t*)(ws + WS_PB), (const bf16_t*)(ws + WO_P0), PD, nullptr, F.wv}; OrdStd S; S.init(T / 256, 4, G, cid);
          EpiPP E{(bf16_t*)(ws + O_PP0)};
          gemm_phase<EpiPP, OrdStd, false>(ring, g, S, E); }
    } SEAM(1);

    if (IN(2)) {
        OrdStd S; S.init(T / 256, 2 * FF / 256, G, cid);
        constexpr bool A8 = (FP8_FFN0 & 1) != 0, O8 = (FP8_FFN0 & 2) != 0;
        if constexpr (I8_UP) {
            Gemm g{(const bf16_t*)(ws + O_H1I8), (const bf16_t*)(ws + WO_F13), D / 2, nullptr, F.wv};
            EpiSwiGLU<true, O8, true> E{(bf16_t*)(ws + O_ACT0), FF, (const float*)(ws + ZO_SQ1), 1.0f / SI8_H, (const float*)(ws + ZO_WMAX)};
            gemm_phase<EpiSwiGLU<true, O8, true>, OrdStd, false, false, true>(ring, g, S, E);
        } else {
        Gemm g{(const bf16_t*)(ws + (A8 ? O_H1F8 : O_H1B)), (const bf16_t*)(ws + WO_F13), A8 ? D / 2 : D, nullptr, F.wv};
        EpiSwiGLU<true, O8> E{(bf16_t*)(ws + O_ACT0), FF, (const float*)(ws + ZO_SQ1), A8 ? 1.0f / (S8_H * S8_W13) : 1.f, nullptr};
        gemm_phase<EpiSwiGLU<true, O8>, OrdStd, false, A8>(ring, g, S, E);
        }
    } SEAM(2);

    if (IN(3)) {
        constexpr bool A8 = (FP8_FFN0 & 2) != 0;
        Gemm g{(const bf16_t*)(ws + O_ACT0), (const bf16_t*)(ws + WO_F2), A8 ? FF / 2 : FF, nullptr, F.wv}; OrdStd S; S.init(T / 256, 4, G, cid);
        EpiResid<true> E{ws + O_H1B, (bf16_t*)(ws + O_H2B), (float*)(ws + ZO_SQ2), part, nullptr, nullptr, A8 ? 1.0f / (S8_ACT * S8_WF2) : 1.f};
        gemm_phase<EpiResid<true>, OrdStd, false, A8>(ring, g, S, E);
    } SEAM(3);

    if (IN(4)) {
        Gemm g{(const bf16_t*)(ws + O_H2B), (const bf16_t*)(ws + WO_G0), D, nullptr, F.wv}; OrdStd S; S.init(T / 256, 4, G, cid);
        EpiPLE<I8_QKV != 0> E{(const bf16_t*)(ws + O_H2B), (const bf16_t*)(ws + O_PP0), (bf16_t*)(ws + O_H3B), (float*)(ws + ZO_SQ3), (const float*)(ws + ZO_SQ2), part, ws + O_H3F8};
        gemm_phase<EpiPLE<I8_QKV != 0>, OrdStd, false>(ring, g, S, E);
    } SEAM(4);

    if (IN(5)) {
        constexpr bool I8Q = I8_QKV != 0;
        const float* wmq = (const float*)(ws + ZO_WMQKV);
        const float qks = I8Q ? 1.0f / SI8_H3 : 1.f;
        { Gemm g{(const bf16_t*)(ws + (I8Q ? O_H3F8 : O_H3B)), (const bf16_t*)(ws + WO_QK), I8Q ? D / 2 : D, nullptr, F.wv}; OrdStd S; S.init(T / 256, 4, G, cid);
          EpiQK<false, I8Q> E{(bf16_t*)(ws + O_Q), ws + O_Q8, ws + O_K8, (const float*)(ws + ZO_SQ3), (const float*)(ws + WS_ROPE), (const float*)(ws + WS_ROPE) + SEQ * 16, (float*)(ws + ZO_KM), wmq, qks};
          gemm_phase<EpiQK<false, I8Q>, OrdStd, false, false, I8Q>(ring, g, S, E); }
        { Gemm g{(const bf16_t*)(ws + (I8Q ? O_H3F8 : O_H3B)), (const bf16_t*)(ws + WO_QK + (size_t)D * D * (I8Q ? 1 : 2)), I8Q ? D / 2 : D, nullptr, F.wv}; OrdStd S; S.init(T / 256, 4, G, cid);
          EpiQK<true, I8Q> E{(bf16_t*)(ws + O_Q), ws + O_Q8, ws + O_K8, (const float*)(ws + ZO_SQ3), (const float*)(ws + WS_ROPE), (const float*)(ws + WS_ROPE) + SEQ * 16, (float*)(ws + ZO_KM), wmq + D, qks};
          gemm_phase<EpiQK<true, I8Q>, OrdStd, false, false, I8Q>(ring, g, S, E); }
        { Gemm g{(const bf16_t*)(ws + WO_V), (const bf16_t*)(ws + O_H3F8), D / 2, nullptr, F.wv}; OrdStd S; S.init(4, T / 256, G, cid);
          EpiVT<I8Q> E{ws + O_VT8, (const float*)(ws + ZO_SQ3), wmq + 2 * D, I8Q ? 1.0f / SI8_H3 : 1.0f / (S8_H * S8_WKV)};
          gemm_phase<EpiVT<I8Q>, OrdStd, false, !I8Q, I8Q>(ring, g, S, E); }
    } SEAM(5);

    if (IN(6)) { moba_select(F);
#if SELFCHECK
        attn_selfcheck_ref(F);
#endif
    } SEAM(6);

    if (IN(7)) { moba_partial(F); } SEAM(7);
    if (IN(8)) { moba_combine(F); } SEAM(8);

    if (IN(9)) {
#if SELFCHECK
        attn_selfcheck_cmp(F); __syncthreads();
#endif
        { Gemm g{(const bf16_t*)(ws + O_Q), (const bf16_t*)(ws + WO_O), D, nullptr, F.wv}; OrdStd S; S.init(T / 256, 4, G, cid);
          EpiResid<true> E{ws + O_H3B, (bf16_t*)(ws + O_H4B), nullptr, part, ws + O_H4F8, nullptr, 1.f};
          gemm_phase<EpiResid<true>, OrdStd, false>(ring, g, S, E); }
        for (int rep = 0; rep < DUPN(3); ++rep) conv_moe_weights(F);
    } SEAM(9);

    if (IN(10)) { moe_router(F); } SEAM(10);
    if (IN(11)) { moe_slots(F); } SEAM(11);

    {
        LAS int* cumt = (LAS int*)(F.lds + TAB_OFF + 4096);
        int ntiles = 0;
        if (hi > 12 && lo <= 12 + NCHUNK) {
            const unsigned* CNT = (const unsigned*)(ws + ZO_CNT);
            if (F.wv == 0 && lane_id() == 0) { int a = 0; for (int e = 0; e < 8; ++e) { cumt[e] = a; a += (int)((CNT[e] + 255u) >> 8); } cumt[8] = a; }
            __syncthreads();
            ntiles = cumt[8];
        }
        const int left = (ntiles >= 256 && ntiles <= 256 + MAXCT) ? ntiles - 256 : 0;
        for (int k = 0; k <= NCHUNK; ++k) {
            if (IN(12 + k)) {
                if (k >= 1) {
                    const int c = k - 1, t0 = (c == 0) ? 0 : left + 64 * (c - 1), ntc = (c == 0) ? left : 64;
                    if (ntc > 0) {
                        Gemm g{(const bf16_t*)(ws + O_ACT1 + (size_t)(c & 1) * RG), (const bf16_t*)(ws + O_WE2), EFF / 2, nullptr, F.wv};
                        OrdMoE S; S.init(t0, ntc, 4, G, cid, D, 1, cumt);
                        EpiMoE2 E{(const int*)(ws + WS_SLOT + 1536 * KiB), (const float*)(ws + WS_SLOT + 1024 * KiB), (bf16_t*)(ws + O_Y1), (bf16_t*)(ws + O_Y2), 1.0f / (S8_ACT * S8_W2)};
                        gemm_phase<EpiMoE2, OrdMoE, false, true>(ring, g, S, E);
                    }
                }
                if (k < NCHUNK) {
                    const int c = k, t0 = (c == 0) ? 0 : left + 64 * (c - 1), ntc = (c == 0) ? left : 64;
                    if (ntc > 0) {
                        Gemm g{(const bf16_t*)(ws + O_H4F8), (const bf16_t*)(ws + O_WE13), D / 2, (const int*)(ws + WS_SLOT), F.wv};
                        OrdMoE S; S.init(t0, ntc, 2 * EFF / 256, G, cid, 2 * EFF, 0, cumt, (k == 1) ? left : 0);
                        EpiSwiGLU<false, true> E{(bf16_t*)(ws + O_ACT1 + (size_t)(c & 1) * RG), EFF, (const float*)(ws + WS_SLOT + 512 * KiB), 1.0f / (S8_H * S8_W13), nullptr};
                        gemm_phase<EpiSwiGLU<false, true>, OrdMoE, true, true>(ring, g, S, E);
                    }
                }
            } SEAM(12 + k);
        }
    }

    if (IN(18)) {
        moe_combine(F);
        { Gemm g{(const bf16_t*)(ws + WS_PB) + (size_t)T * PD, (const bf16_t*)(ws + WO_P1), PD, nullptr, F.wv}; OrdStd S; S.init(T / 256, 4, G, cid);
          EpiPP E{(bf16_t*)(ws + O_PP1)};
          gemm_phase<EpiPP, OrdStd, false>(ring, g, S, E); }
    } SEAM(18);

    if (IN(19)) {
        Gemm g{(const bf16_t*)(ws + O_H5B), (const bf16_t*)(ws + WO_G1), D, nullptr, F.wv}; OrdStd S; S.init(T / 256, 4, G, cid);
        EpiPLE<false> E{(const bf16_t*)(ws + O_H5B), (const bf16_t*)(ws + O_PP1), (bf16_t*)(ws + O_H6B), (float*)(ws + ZO_SQ6), (const float*)(ws + ZO_SQ5), part, nullptr};
        gemm_phase<EpiPLE<false>, OrdStd, false>(ring, g, S, E);
    } SEAM(19);

    if (IN(20)) { final_norm(F); }
#undef IN
#undef SEAM
}

extern "C" void kernel_launch(void* const* d_in, const int* in_sizes, int n_in, void* d_out, int out_size, void* d_ws, size_t ws_size, hipStream_t stream) {
    static int grid = 0;
    if (grid == 0) {
        if (n_in != 23 || in_sizes[0] != T * D || out_size != T * D || ws_size < WS_END) {
            fprintf(stderr, "kernel_launch: unexpected shapes or workspace (n_in %d, in0 %d, out %d, ws %zu, need %zu); nothing launched\n", n_in, n_in > 0 ? in_sizes[0] : -1, out_size, ws_size, (size_t)WS_END);
            grid = -1; return; }
        int dev = 0, cus = 0, per_cu = 0;
        if (hipGetDevice(&dev) != hipSuccess || hipDeviceGetAttribute(&cus, hipDeviceAttributeMultiprocessorCount, dev) != hipSuccess) { grid = -1; return; }
        if (hipFuncSetAttribute((const void*)fwd_kernel, hipFuncAttributeMaxDynamicSharedMemorySize, LDS_BYTES) != hipSuccess) { fprintf(stderr, "kernel_launch: hipFuncSetAttribute failed\n"); grid = -1; return; }
        if (hipOccupancyMaxActiveBlocksPerMultiprocessor(&per_cu, (const void*)fwd_kernel, 512, LDS_BYTES) != hipSuccess || per_cu < 1) { fprintf(stderr, "kernel_launch: occupancy query reports %d blocks per CU\n", per_cu); }
        (void)hipGetLastError();
        grid = cus;
    }
    if (grid < 0) return;
    if (hipMemsetAsync((char*)d_ws + WS_ZERO, 0, ZERO_BYTES, stream) != hipSuccess) { fprintf(stderr, "kernel_launch: memset failed\n"); return; }
    Args a{};
    for (int i = 0; i < 23; ++i) a.in[i] = (const float*)d_in[i];
    a.out = (float*)d_out; a.ws = (unsigned char*)d_ws;
    if (MK_N_LAUNCHES == 1) {
        a.ph_lo = 0; a.ph_hi = NPH;
        hipLaunchKernelGGL(fwd_kernel, dim3(grid), dim3(512), LDS_BYTES, stream, a);
    } else {
        for (int ph = 0; ph < NPH; ++ph) { a.ph_lo = ph; a.ph_hi = ph + 1; hipLaunchKernelGGL(fwd_kernel, dim3(grid), dim3(512), LDS_BYTES, stream, a); }
    }
    const hipError_t le = hipPeekAtLastError();
    if (le != hipSuccess) fprintf(stderr, "kernel_launch: launch failed: %s\n", hipGetErrorName(le));
}
```

```cpp
#include <hip/hip_runtime.h>
#include <cstdio>
#include <cstdint>

#define LAS __attribute__((address_space(3)))
#define DI __device__ __forceinline__
typedef unsigned short bf16_t;
typedef short bf16x8 __attribute__((ext_vector_type(8)));
typedef short s16x4 __attribute__((ext_vector_type(4)));
typedef float f32x4 __attribute__((ext_vector_type(4)));
typedef float f32x2 __attribute__((ext_vector_type(2)));
typedef float f32x16 __attribute__((ext_vector_type(16)));
typedef unsigned u32x4 __attribute__((ext_vector_type(4)));
typedef unsigned u32x2 __attribute__((ext_vector_type(2)));
typedef __bf16 bf16x2_t __attribute__((ext_vector_type(2)));
typedef int i32x4 __attribute__((ext_vector_type(4)));
typedef int i32x8 __attribute__((ext_vector_type(8)));

#ifndef PROBE_DUP
#define PROBE_DUP 0
#endif
#define DUPN(id) ((PROBE_DUP == (id)) ? 2 : 1)
#ifndef FP8_FFN0
#define FP8_FFN0 0
#endif
#ifndef SELFCHECK
#define SELFCHECK 0
#endif
#ifndef SELFCHECK_TOL
#define SELFCHECK_TOL 0.03f
#endif
#ifndef I8_UP
#define I8_UP 1
#endif
#ifndef I8_QKV
#define I8_QKV 1
#endif
#ifndef MK_N_LAUNCHES
#define MK_N_LAUNCHES 1
#endif

constexpr int BATCH = 2, SEQ = 16384, T = BATCH * SEQ, D = 1024, NH = 8, HD = 128, NBLK = 64;
constexpr int FF = 2816, EFF = 3584, NE = 8, PD = 256;
constexpr float EPS = 1e-6f;
constexpr float S8_H = 8.f, S8_W13 = 64.f, S8_ACT = 4.f, S8_W2 = 128.f, S8_WF2 = 64.f, S8_PO = 32.f, S8_QK = 16.f, S8_V = 16.f, S8_P = 256.f, S8_WKV = 64.f;
constexpr float SI8_H = 32.f;
constexpr float SI8_H3 = 24.f;
static_assert(S8_P == 256.f, "the attention softmax folds log2(S8_P) = 8 into its exponent");
constexpr int ATT_C = 6;
constexpr int NCHUNK = 5;
constexpr int MAXCT = 64;

constexpr size_t MiB = (size_t)1 << 20, KiB = 1024;
constexpr size_t WS_ZERO = 0, ZERO_BYTES = 1536 * KiB;
constexpr size_t ZO_BAR = 0;
constexpr size_t ZO_WMAX = 72 * KiB;
constexpr size_t ZO_WMQKV = ZO_WMAX + 2 * 2816 * 4;
constexpr size_t ZO_CNT = 64 * KiB;
constexpr size_t ZO_LCNT = 128 * KiB;
constexpr size_t ZO_SQ1 = 1536 * KiB, ZO_SQ2 = 2048 * KiB, ZO_SQ3 = 2560 * KiB, ZO_SQ5 = 3072 * KiB, ZO_SQ6 = 3584 * KiB;
constexpr size_t ZO_KM = 1 * MiB;
constexpr size_t WS_ROPE = 4 * MiB;
constexpr size_t WS_TOP = 6 * MiB;
constexpr size_t WS_SLOT = 7 * MiB;
constexpr size_t WS_WS = 9 * MiB;
constexpr size_t WO_POOL = WS_WS, WO_F13 = WO_POOL + MiB / 2, WO_F2 = WO_F13 + 11 * MiB, WO_G0 = WO_F2 + 11 * MiB / 2, WO_G1 = WO_G0 + 2 * MiB,
                 WO_P0 = WO_G1 + 2 * MiB, WO_P1 = WO_P0 + MiB / 2, WO_QK = WO_P1 + MiB / 2, WO_V = WO_QK + 4 * MiB, WO_O = WO_V + 2 * MiB;
constexpr size_t WS_PB = 39 * MiB;
constexpr size_t WS_R = 71 * MiB;
constexpr size_t RG = 64 * MiB;
constexpr size_t R_A = WS_R, R_B = WS_R + RG, R_C = WS_R + 2 * RG, R_D = WS_R + 3 * RG, R_E = WS_R + 4 * RG, R_G = WS_R + 5 * RG, R_I = WS_R + 6 * RG, R_J = WS_R + 7 * RG;
constexpr size_t WS_END = WS_R + 8 * RG;
static_assert(WO_O + 2 * MiB == WS_PB, "small weight map");
constexpr size_t O_H3F8 = R_J, O_H1I8 = R_J, O_H1F8 = R_J, O_POOLED = R_A, O_H1B = R_B, O_PP0 = R_C, O_ACT0 = R_D, O_H2B = R_A, O_H3B = R_B;
constexpr size_t O_Q = R_A, O_K8 = R_C, O_Q8 = R_C + 32 * MiB, O_VT8 = R_D, O_LIST = R_E, O_ML = R_E + 32 * MiB, O_PO = R_G;
constexpr size_t O_H4B = R_B, O_H4F8 = R_J, O_WE13 = R_I, O_WE2 = R_E, O_ACT1 = R_C, O_Y1 = R_A, O_Y2 = R_G, O_H5B = R_B, O_PP1 = R_C, O_H6B = R_A;

constexpr int RING_BYTES = 131072;
constexpr int LDSCTL_OFF = RING_BYTES;
constexpr int MISC_OFF = LDSCTL_OFF + 320;
constexpr int TAB_OFF = LDSCTL_OFF + 1024;
constexpr int LDS_BYTES = 147456;

DI unsigned pk2(float a, float b) { f32x2 v = {a, b}; return __builtin_bit_cast(unsigned, __builtin_convertvector(v, bf16x2_t)); }
DI unsigned pk4_fp8(float a, float b, float c, float d) {
    a = __builtin_amdgcn_fmed3f(a, -448.f, 448.f); b = __builtin_amdgcn_fmed3f(b, -448.f, 448.f); c = __builtin_amdgcn_fmed3f(c, -448.f, 448.f); d = __builtin_amdgcn_fmed3f(d, -448.f, 448.f);
    unsigned w = 0u; w = (unsigned)__builtin_amdgcn_cvt_pk_fp8_f32(a, b, (int)w, false); w = (unsigned)__builtin_amdgcn_cvt_pk_fp8_f32(c, d, (int)w, true); return w; }
DI unsigned pk4_i8(float a, float b, float c, float d) {
    const int ia = (int)__builtin_rintf(__builtin_amdgcn_fmed3f(a, -127.f, 127.f)), ib = (int)__builtin_rintf(__builtin_amdgcn_fmed3f(b, -127.f, 127.f));
    const int ic = (int)__builtin_rintf(__builtin_amdgcn_fmed3f(c, -127.f, 127.f)), id = (int)__builtin_rintf(__builtin_amdgcn_fmed3f(d, -127.f, 127.f));
    return ((unsigned)ia & 255u) | (((unsigned)ib & 255u) << 8) | (((unsigned)ic & 255u) << 16) | ((unsigned)id << 24); }
DI float bf_lo(unsigned u) { return __uint_as_float(u << 16); }
DI float bf_hi(unsigned u) { return __uint_as_float(u & 0xffff0000u); }
DI float fexp2(float x) { return __builtin_amdgcn_exp2f(x); }
DI float frcp(float x) { return __builtin_amdgcn_rcpf(x); }
DI float sigmoidf_(float a) { return frcp(1.0f + fexp2(-1.4426950408889634f * a)); }
DI unsigned lds_add(LAS unsigned* p, unsigned v) { return __hip_atomic_fetch_add(p, v, __ATOMIC_RELAXED, __HIP_MEMORY_SCOPE_WORKGROUP); }
DI int lane_id() { int r; asm volatile("v_mbcnt_lo_u32_b32 %0, -1, 0\n\tv_mbcnt_hi_u32_b32 %0, -1, %0" : "=v"(r)); return r; }
DI float wave_sum(float v) { v += __shfl_xor(v, 32); v += __shfl_xor(v, 16); v += __shfl_xor(v, 8); v += __shfl_xor(v, 4); v += __shfl_xor(v, 2); v += __shfl_xor(v, 1); return v; }

#define XB_TMO      128
#define XB_XCNT(j)  (256  + 64 * (j))
#define XB_XSUB(j)  (1280 + 64 * (j))
#define XB_XGEN(j)  (2304 + 64 * (j))
#define XB_TOP      3328
#define XB_TOPGEN   3392
#define XCD_BAR_WORDS 3456
#define XB_SPIN_CAP (1u << 18)
__device__ __forceinline__ unsigned xb_ld(unsigned* p)              { return __hip_atomic_load(p, __ATOMIC_RELAXED, __HIP_MEMORY_SCOPE_AGENT); }
__device__ __forceinline__ unsigned xb_add(unsigned* p, unsigned v) { return __hip_atomic_fetch_add(p, v, __ATOMIC_RELAXED, __HIP_MEMORY_SCOPE_AGENT); }
__device__ __forceinline__ unsigned xb_xcc_id() { return (unsigned)__builtin_amdgcn_s_getreg((3 << 11) | 20) & 0xFu; }
#define XB_SPIN(cond, bar) do { unsigned _sp = 0; while (cond) { __builtin_amdgcn_s_sleep(1); \
    if ((++_sp & 255u) == 0u) { if (xb_ld(&(bar)[XB_TMO])) break; if (_sp > XB_SPIN_CAP) { atomicAdd(&(bar)[XB_TMO], 1u); break; } } } } while (0)
struct XcdBarrier { unsigned* bar; unsigned x; volatile LAS unsigned* st; };
__device__ __forceinline__ XcdBarrier xcd_barrier_post(unsigned* bar, volatile LAS unsigned* st, bool leader) {
    XcdBarrier b; b.bar = bar; b.x = xb_xcc_id(); b.st = st;
    if (leader) (void)xb_add(&bar[XB_XCNT(b.x)], 1u);
    return b;
}
__device__ __forceinline__ void xcd_barrier_complete(unsigned* bar, unsigned x, unsigned& nloc, unsigned& nx) {
    const unsigned G = gridDim.x * gridDim.y * gridDim.z;
    unsigned sum, cnt, mine, sp = 0u;
    for (;;) {
        sum = 0u; cnt = 0u; mine = 0u;
#pragma unroll
        for (unsigned j = 0; j < 16; ++j) { const unsigned c = xb_ld(&bar[XB_XCNT(j)]); sum += c; cnt += (c > 0u) ? 1u : 0u; mine = (j == x) ? c : mine; }
        if (sum == G) break;
        __builtin_amdgcn_s_sleep(1);
        if ((++sp & 255u) == 0u) { if (xb_ld(&bar[XB_TMO])) break; if (sp > XB_SPIN_CAP) { atomicAdd(&bar[XB_TMO], 1u); break; } }
    }
    nloc = mine > 0u ? mine : 1u; nx = cnt > 0u ? cnt : 1u;
}
__device__ __forceinline__ void xcd_barrier(const XcdBarrier& b, bool leader) {
    asm volatile("s_waitcnt vmcnt(0)" ::: "memory");
    __syncthreads();
    if (leader) {
        unsigned* bar = b.bar;
        __builtin_amdgcn_s_waitcnt(0);
        unsigned nloc = b.st[0], nx = b.st[1];
        if (nloc == 0u) { xcd_barrier_complete(bar, b.x, nloc, nx); b.st[0] = nloc; b.st[1] = nx; }
        const unsigned old = xb_add(&bar[XB_XSUB(b.x)], 1u);
        const unsigned gen = old / nloc;
        if (old + 1u == (gen + 1u) * nloc) {
            __builtin_amdgcn_fence(__ATOMIC_RELEASE, "agent");
            asm volatile("s_waitcnt vmcnt(0)" ::: "memory");
            const unsigned og = xb_add(&bar[XB_TOP], 1u);
            const unsigned tg = og / nx;
            if (og + 1u == (tg + 1u) * nx) xb_add(&bar[XB_TOPGEN], 1u);
            else XB_SPIN(xb_ld(&bar[XB_TOPGEN]) == tg, bar);
            __builtin_amdgcn_fence(__ATOMIC_ACQUIRE, "agent");
            xb_add(&bar[XB_XGEN(b.x)], 1u);
            asm volatile("s_waitcnt vmcnt(0)" ::: "memory");
        } else {
            XB_SPIN(xb_ld(&bar[XB_XGEN(b.x)]) == gen, bar);
            __builtin_amdgcn_fence(__ATOMIC_ACQUIRE, "agent");
            asm volatile("s_waitcnt vmcnt(0)" ::: "memory");
        }
    }
    __syncthreads();
}

namespace pg8 {
constexpr int BM = 256, BK = 64, HALF = 128, HTB = HALF * BK * 2, NXCD = 8, WGM = 8;
__host__ __device__ __forceinline__ int lds_byte(int r, int c) { const int st = (r >> 4) * 2 + (c >> 5), rr = r & 15, cc = c & 31, ob = rr * 64 + cc * 2; return st * 1024 + (ob ^ (((ob >> 9) & 1) << 5)); }
__host__ __device__ __forceinline__ void stage_rc(int b, int& R, int& C) { const int st = b / 1024, sb = b % 1024, swz = sb ^ (((sb >> 9) & 1) << 5); R = (st >> 1) * 16 + swz / 64; C = (st & 1) * 32 + (swz % 64) / 2; }
__host__ __device__ __forceinline__ int perm32(int rho) { const int n = rho >> 4, i = rho & 15; return 8 * (i >> 2) + 4 * n + (i & 3); }

struct Unit { int pm, pn, arow, brow; };
struct Gemm { const bf16_t* A; const bf16_t* Bt; int K; const int* rowidx; int wv; };

struct TileOrder {
    int nM, nN, nwg, G, c;
    __device__ void init(int nM_, int nN_, int G_, int c_) { nM = nM_; nN = nN_; nwg = nM * nN; G = G_; c = c_; }
    __device__ bool tile(int i, int& pm, int& pn) const {
        const long L = (long)i * G + c; if (L >= nwg) return false;
        int wgid = (int)L; { const int q = nwg / NXCD, r = nwg % NXCD, xcd = wgid % NXCD, off = wgid / NXCD; wgid = (xcd < r ? xcd * (q + 1) : r * (q + 1) + (xcd - r) * q) + off; }
        const int nig = WGM * nN, gid = wgid / nig, fm = gid * WGM, gsz = (nM - fm) < WGM ? (nM - fm) : WGM;
        pm = fm + ((wgid % nig) % gsz); pn = (wgid % nig) / gsz; return true;
    }
};
struct OrdStd : TileOrder {
    __device__ bool next(int i, Unit& u) const { int pm, pn; if (!tile(i, pm, pn)) return false; u.pm = pm; u.pn = pn; u.arow = pm * BM; u.brow = pn * BM; return true; }
};
struct OrdPool : TileOrder {
    __device__ bool next(int i, Unit& u) const { int pm, pn; if (!tile(i, pm, pn)) return false; u.pm = pm; u.pn = pn; u.arow = pn * T + pm * BM; u.brow = pn * BM; return true; }
};
struct OrdMoE {
    int t0, ntc, npn, nb, nxc, xcd, rank, brow_e, second, light; const LAS int* cumt;
    __device__ __forceinline__ void init(int t0_, int ntc_, int npn_, int G, int c, int brow_e_, int second_, const LAS int* cumt_, int light_xcds = 0) {
        t0 = t0_; ntc = ntc_; npn = npn_; brow_e = brow_e_; second = second_; cumt = cumt_;
        if (G % 8 == 0) { nxc = 8; nb = G / 8; xcd = c % 8; rank = c / 8; } else { nxc = 1; nb = G; xcd = 0; rank = c; }
        light = (nxc == 8 && nb == 32 && xcd < light_xcds) ? 1 : 0;
    }
    __device__ __forceinline__ bool next(int i, Unit& u) const {
        const int nx = (ntc > xcd) ? (ntc - xcd + nxc - 1) / nxc : 0;
        const int nu = nx * npn;
        long j;
        if (light && nu == 224) {
            const int start = (rank < 4) ? 4 * rank : (rank < 16) ? 16 + 8 * (rank - 4) : 112 + 7 * (rank - 16);
            const int cnt = (rank < 4) ? 4 : (rank < 16) ? 8 : 7;
            if (i >= cnt) return false;
            j = start + i;
        } else { j = (long)i * nb + rank; if (j >= (long)nu) return false; }
        const int tlx = (int)(j % nx), pn = (int)(j / nx), tl = xcd + nxc * tlx, tile = t0 + tl;
        int e = 0;
#pragma unroll
        for (int k = 1; k < 8; ++k) e += (tile >= cumt[k]) ? 1 : 0;
        u.pn = pn; u.brow = e * brow_e + pn * BM;
        if (second) { u.pm = tile; u.arow = tl * BM; } else { u.pm = tl; u.arow = tile * BM; }
        return true;
    }
};

template <class Epi, class Sched, bool GATHER, bool FP8 = false, bool I8 = false>
__device__ __forceinline__ void gemm_phase(LAS unsigned char* lds, const Gemm g, const Sched& S, const Epi& E) {
    int wvv = g.wv; asm volatile("" : "+s"(wvv));
    int tid = wvv * 64 + lane_id(); asm volatile("" : "+v"(tid));
    const int wid = __builtin_amdgcn_readfirstlane(tid >> 6), lane = tid & 63, wr = wid >> 2, wc = wid & 3, fr = lane & 15, fq = lane >> 4;
    int K = g.K; asm volatile("" : "+s"(K)); const int nt = K / BK;
    unsigned voffA[2], voffB[2]; int RA[2]; unsigned CA[2];
#pragma unroll
    for (int i = 0; i < 2; ++i) { int R, C; stage_rc(tid * 16 + i * 8192, R, C); const int Rb = (R & ~31) + perm32(R & 31);
        voffA[i] = (unsigned)(R * K + C) * 2u; voffB[i] = (unsigned)(Rb * K + C) * 2u; RA[i] = R; CA[i] = (unsigned)C * 2u; }
    const size_t kstep = (size_t)(BK * 2);
    const size_t hstep = (size_t)HALF * K * 2;
    const unsigned hstepu = (unsigned)(HALF * K * 2);
    const size_t rstep = (size_t)K * 2;
    const unsigned ldsw = (unsigned)wid * 1024u;
    const int aoff = lds_byte(wr * 64 + fr, fq * 8), boff = lds_byte(wc * 32 + fr, fq * 8);
#define PG8_SA(b, h) (((b) * 2 + (h)) * HTB)
#define PG8_SB(b, h) ((4 + (b) * 2 + (h)) * HTB)
#define PG8_STAGE(bufoff, gbase, voff) do { _Pragma("unroll") for (int _i = 0; _i < 2; ++_i) \
        __builtin_amdgcn_global_load_lds((const unsigned*)((const char*)(gbase) + (voff)[_i]), (LAS unsigned*)(lds + (bufoff) + ldsw + _i * 8192), 16, 0, 0); } while (0)
#define PG8_CAT(a, b) __builtin_shufflevector(a, b, 0, 1, 2, 3, 4, 5, 6, 7)
#define PG8_LO(v) __builtin_bit_cast(bf16x8, __builtin_shufflevector(v, v, 0, 1, 2, 3))
#define PG8_HI(v) __builtin_bit_cast(bf16x8, __builtin_shufflevector(v, v, 4, 5, 6, 7))
#define PG8_LDA(dst, b, h) do { _Pragma("unroll") for (int m = 0; m < 4; ++m) dst[m] = PG8_CAT(*(const LAS i32x4*)(lds + PG8_SA(b, h) + aoff + m * 2048), *(const LAS i32x4*)(lds + PG8_SA(b, h) + aoff + m * 2048 + 1024)); } while (0)
#define PG8_LDB(dst, b, h) do { _Pragma("unroll") for (int n = 0; n < 2; ++n) dst[n] = PG8_CAT(*(const LAS i32x4*)(lds + PG8_SB(b, h) + boff + n * 2048), *(const LAS i32x4*)(lds + PG8_SB(b, h) + boff + n * 2048 + 1024)); } while (0)
#define PG8_MMAZ(ai, bj, At, Bt, Z) do { __builtin_amdgcn_s_setprio(1); \
        if constexpr (FP8) { _Pragma("unroll") for (int m = 0; m < 4; ++m) _Pragma("unroll") for (int n = 0; n < 2; ++n) { \
            if constexpr (Z) asm volatile("v_mfma_scale_f32_16x16x128_f8f6f4 %0, %1, %2, 0, %3, %3 op_sel_hi:[0,0,0]" : "=&v"(acc[ai][bj][m][n]) : "v"(Bt[n]), "v"(At[m]), "v"(one_e8m0)); \
            else asm volatile("v_mfma_scale_f32_16x16x128_f8f6f4 %0, %1, %2, %0, %3, %3 op_sel_hi:[0,0,0]" : "+v"(acc[ai][bj][m][n]) : "v"(Bt[n]), "v"(At[m]), "v"(one_e8m0)); } } \
        else if constexpr (I8) { \
            _Pragma("unroll") for (int m = 0; m < 4; ++m) _Pragma("unroll") for (int n = 0; n < 2; ++n) { \
                if constexpr (Z) asm volatile("v_mfma_i32_16x16x64_i8 %0, %1, %2, 0" : "=&v"(acc[ai][bj][m][n]) : "v"(__builtin_shufflevector(Bt[n], Bt[n], 0, 1, 2, 3)), "v"(__builtin_shufflevector(At[m], At[m], 0, 1, 2, 3))); \
                else asm volatile("v_mfma_i32_16x16x64_i8 %0, %1, %2, %0" : "+v"(acc[ai][bj][m][n]) : "v"(__builtin_shufflevector(Bt[n], Bt[n], 0, 1, 2, 3)), "v"(__builtin_shufflevector(At[m], At[m], 0, 1, 2, 3))); } \
            _Pragma("unroll") for (int m = 0; m < 4; ++m) _Pragma("unroll") for (int n = 0; n < 2; ++n) \
                asm volatile("v_mfma_i32_16x16x64_i8 %0, %1, %2, %0" : "+v"(acc[ai][bj][m][n]) : "v"(__builtin_shufflevector(Bt[n], Bt[n], 4, 5, 6, 7)), "v"(__builtin_shufflevector(At[m], At[m], 4, 5, 6, 7))); } \
        else {   \
            _Pragma("unroll") for (int m = 0; m < 4; ++m) _Pragma("unroll") for (int n = 0; n < 2; ++n) { \
                if constexpr (Z) asm volatile("v_mfma_f32_16x16x32_bf16 %0, %1, %2, 0" : "=&v"(acc[ai][bj][m][n]) : "v"(PG8_LO(Bt[n])), "v"(PG8_LO(At[m]))); \
                else asm volatile("v_mfma_f32_16x16x32_bf16 %0, %1, %2, %0" : "+v"(acc[ai][bj][m][n]) : "v"(PG8_LO(Bt[n])), "v"(PG8_LO(At[m]))); } \
            _Pragma("unroll") for (int m = 0; m < 4; ++m) _Pragma("unroll") for (int n = 0; n < 2; ++n) \
                asm volatile("v_mfma_f32_16x16x32_bf16 %0, %1, %2, %0" : "+v"(acc[ai][bj][m][n]) : "v"(PG8_HI(Bt[n])), "v"(PG8_HI(At[m]))); } \
        __builtin_amdgcn_s_setprio(0); } while (0)
#define PG8_WAIT_V(n) asm volatile("s_waitcnt vmcnt(" #n ")" ::: "memory")
#define PG8_WAIT_L(n) asm volatile("s_waitcnt lgkmcnt(" #n ")" ::: "memory")
#define PG8_BAR __builtin_amdgcn_s_barrier()
#define PG8_SCHED __builtin_amdgcn_sched_barrier(0)
#define PG8_AOFF(u, v0, v1) do { if constexpr (GATHER) { _Pragma("unroll") for (int _i = 0; _i < 2; ++_i) { \
            const unsigned r0 = (unsigned)g.rowidx[(u).arow + RA[_i]], r1 = (unsigned)g.rowidx[(u).arow + HALF + RA[_i]]; \
            v0[_i] = r0 * (unsigned)(K * 2) + CA[_i]; v1[_i] = r1 * (unsigned)(K * 2) + CA[_i]; } } \
        else { _Pragma("unroll") for (int _i = 0; _i < 2; ++_i) { v0[_i] = voffA[_i]; v1[_i] = voffA[_i] + hstepu; } } } while (0)
#define PG8_ABASE(u) (GATHER ? (const char*)g.A : (const char*)g.A + (size_t)(u).arow * rstep)
    Unit cur, nxt; int ui = 0;
    if (!S.next(0, cur)) return;
    f32x4 acc[2][2][4][2];
#define PG8_CLEAR() do { if constexpr (false) { _Pragma("unroll") for (int a = 0; a < 2; ++a) _Pragma("unroll") for (int b = 0; b < 2; ++b) _Pragma("unroll") for (int m = 0; m < 4; ++m) _Pragma("unroll") for (int n = 0; n < 2; ++n) \
        acc[a][b][m][n] = (f32x4){0.f, 0.f, 0.f, 0.f}; } } while (0)
    PG8_CLEAR();
    i32x8 At[4], B0[2], B1[2];
    const int one_e8m0 = 0x7F7F7F7F; (void)one_e8m0;
    unsigned cv0[2], cv1[2], nv0[2], nv1[2];
    PG8_AOFF(cur, cv0, cv1);
    const char* cA = PG8_ABASE(cur); const char* cB = (const char*)g.Bt + (size_t)cur.brow * rstep;
    PG8_STAGE(PG8_SB(0, 0), cB, voffB); PG8_STAGE(PG8_SB(0, 1), cB + hstep, voffB); PG8_STAGE(PG8_SA(0, 0), cA, cv0); PG8_STAGE(PG8_SA(0, 1), cA, cv1);
    if (wr == 1) PG8_BAR;
    PG8_WAIT_V(2); PG8_BAR;
    PG8_STAGE(PG8_SB(1, 0), cB + kstep, voffB); PG8_STAGE(PG8_SA(1, 0), cA + kstep, cv0); PG8_STAGE(PG8_SB(1, 1), cB + hstep + kstep, voffB);
    PG8_WAIT_V(6); PG8_BAR;
    for (;;) {
        const bool has_next = S.next(ui + 1, nxt);
        const char* nA = cA; const char* nB = cB;
#pragma unroll
        for (int i = 0; i < 2; ++i) { nv0[i] = cv0[i]; nv1[i] = cv1[i]; }
        if (has_next) { nA = PG8_ABASE(nxt); nB = (const char*)g.Bt + (size_t)nxt.brow * rstep; PG8_AOFF(nxt, nv0, nv1); }
#define PG8_KITER(t, Z) do { \
            const bool last = ((t) == nt - 2); \
            const char* a1 = cA + (size_t)((t) + 1) * kstep; \
            const char* a2 = last ? nA : cA + (size_t)((t) + 2) * kstep; const char* b2 = last ? nB : cB + (size_t)((t) + 2) * kstep; \
            const char* a3 = a2 + kstep; const char* b3 = b2 + kstep; \
            unsigned s0[2], s1[2]; \
            _Pragma("unroll") for (int i = 0; i < 2; ++i) { s0[i] = last ? nv0[i] : cv0[i]; s1[i] = last ? nv1[i] : cv1[i]; } \
              \
            PG8_LDB(B0, 0, 0); PG8_LDB(B1, 0, 1); PG8_SCHED; PG8_LDA(At, 0, 0); PG8_STAGE(PG8_SA(1, 1), a1, cv1); \
            PG8_WAIT_V(8); PG8_WAIT_L(0); PG8_BAR; PG8_MMAZ(0, 0, At, B0, Z); PG8_MMAZ(0, 1, At, B1, Z); PG8_BAR; PG8_SCHED; \
              \
            PG8_LDA(At, 0, 1); PG8_STAGE(PG8_SB(0, 0), b2, voffB); PG8_STAGE(PG8_SB(0, 1), b2 + hstep, voffB); PG8_STAGE(PG8_SA(0, 0), a2, s0); \
            PG8_WAIT_V(8); PG8_WAIT_L(0); PG8_BAR; PG8_MMAZ(1, 0, At, B0, Z); PG8_MMAZ(1, 1, At, B1, Z); PG8_BAR; PG8_SCHED; \
              \
            PG8_LDB(B0, 1, 0); PG8_LDB(B1, 1, 1); PG8_SCHED; PG8_LDA(At, 1, 0); PG8_STAGE(PG8_SA(0, 1), a2, s1); \
            PG8_WAIT_V(8); PG8_WAIT_L(0); PG8_BAR; PG8_MMAZ(0, 0, At, B0, false); PG8_MMAZ(0, 1, At, B1, false); PG8_BAR; PG8_SCHED; \
              \
            PG8_LDA(At, 1, 1); PG8_STAGE(PG8_SB(1, 0), b3, voffB); PG8_STAGE(PG8_SB(1, 1), b3 + hstep, voffB); PG8_STAGE(PG8_SA(1, 0), a3, s0); \
            PG8_WAIT_V(8); PG8_WAIT_L(0); PG8_BAR; PG8_MMAZ(1, 0, At, B0, false); PG8_MMAZ(1, 1, At, B1, false); PG8_BAR; PG8_SCHED; \
        } while (0)
        PG8_KITER(0, true);
        for (int t = 2; t < nt; t += 2) PG8_KITER(t, false);
        asm volatile("s_nop 7\n\ts_nop 7\n\ts_nop 7" ::: "memory");
        if (wr == 0) PG8_BAR;
        E(acc, cur, wr, wc, fr, fq);
        if (!has_next) break;
        PG8_CLEAR();
        cur = nxt; cA = nA; cB = nB; ++ui;
#pragma unroll
        for (int i = 0; i < 2; ++i) { cv0[i] = nv0[i]; cv1[i] = nv1[i]; }
        if (wr == 1) PG8_BAR;
    }
    PG8_WAIT_V(0);
    PG8_BAR;
#undef PG8_SA
#undef PG8_SB
#undef PG8_STAGE
#undef PG8_LDA
#undef PG8_LDB
#undef PG8_MMAZ
#undef PG8_KITER
#undef PG8_CLEAR
#undef PG8_CAT
#undef PG8_LO
#undef PG8_HI
#undef PG8_WAIT_V
#undef PG8_WAIT_L
#undef PG8_BAR
#undef PG8_SCHED
#undef PG8_AOFF
#undef PG8_ABASE
}

typedef f32x4 Acc[2][2][4][2];

DI void sq_store(LAS float* part, float* sq, const Unit& u, int wr, int wc, int fr, int fq) {
    asm volatile("s_waitcnt lgkmcnt(0)" ::: "memory"); __builtin_amdgcn_s_barrier(); asm volatile("" ::: "memory");
    const int t = (wr * 4 + wc) * 64 + fq * 16 + fr;
    if (t < 256) { const f32x4 p = *(const LAS f32x4*)(part + t * 4); sq[(size_t)(u.pm * BM + t) * 4 + u.pn] = (p[0] + p[1]) + (p[2] + p[3]); }
}
DI float sq_rstd(const float* sq, int row) { const f32x4 p = *(const f32x4*)(sq + (size_t)row * 4); return __builtin_amdgcn_rsqf(((p[0] + p[1]) + (p[2] + p[3])) * (1.0f / D) + EPS); }

template <bool RIN_BF16> struct EpiResid {
    const void* rin; bf16_t* hb; float* sq; LAS float* part; unsigned char* h8; unsigned char* hi8; float ascale;
    DI void operator()(const Acc& acc, const Unit& u, int wr, int wc, int fr, int fq) const {
        const int row0 = u.pm * BM + wr * 64 + fr, col0 = u.pn * BM + wc * 32 + 8 * fq;
#pragma unroll
        for (int ai = 0; ai < 2; ++ai) {
            f32x4 ra[4][2], rb[4][2];
#pragma unroll
            for (int m = 0; m < 4; ++m) { const size_t base = (size_t)(row0 + ai * HALF + m * 16) * D + col0;
#pragma unroll
                for (int bj = 0; bj < 2; ++bj) {
                    if constexpr (RIN_BF16) { const u32x4 rw = *(const u32x4*)((const bf16_t*)rin + base + bj * HALF);
                        ra[m][bj] = (f32x4){bf_lo(rw.x), bf_hi(rw.x), bf_lo(rw.y), bf_hi(rw.y)}; rb[m][bj] = (f32x4){bf_lo(rw.z), bf_hi(rw.z), bf_lo(rw.w), bf_hi(rw.w)}; }
                    else { const float* rp = (const float*)rin + base + bj * HALF; ra[m][bj] = *(const f32x4*)rp; rb[m][bj] = *(const f32x4*)(rp + 4); } } }
#pragma unroll
            for (int m = 0; m < 4; ++m) {
                const int row = row0 + ai * HALF + m * 16; const size_t base = (size_t)row * D + col0; float ss = 0.f;
#pragma unroll
                for (int bj = 0; bj < 2; ++bj) {
                    const f32x4 a = ra[m][bj] + acc[ai][bj][m][0] * ascale, b = rb[m][bj] + acc[ai][bj][m][1] * ascale;
                    { u32x4 w; w.x = pk2(a[0], a[1]); w.y = pk2(a[2], a[3]); w.z = pk2(b[0], b[1]); w.w = pk2(b[2], b[3]); *(u32x4*)(hb + base + bj * HALF) = w; }
                    if (h8) { u32x2 w; w.x = pk4_fp8(a[0] * S8_H, a[1] * S8_H, a[2] * S8_H, a[3] * S8_H); w.y = pk4_fp8(b[0] * S8_H, b[1] * S8_H, b[2] * S8_H, b[3] * S8_H); *(u32x2*)(h8 + base + bj * HALF) = w; }
                    if (hi8) *(u32x2*)(hi8 + base + bj * HALF) = (u32x2){pk4_i8(a[0] * SI8_H, a[1] * SI8_H, a[2] * SI8_H, a[3] * SI8_H), pk4_i8(b[0] * SI8_H, b[1] * SI8_H, b[2] * SI8_H, b[3] * SI8_H)};
                    ss += (a[0] * a[0] + a[1] * a[1]) + (a[2] * a[2] + a[3] * a[3]) + (b[0] * b[0] + b[1] * b[1]) + (b[2] * b[2] + b[3] * b[3]);
                }
                if (sq) { ss += __shfl_xor(ss, 16); ss += __shfl_xor(ss, 32); if (fq == 0) part[(wr * 64 + fr + ai * HALF + m * 16) * 4 + wc] = ss; }
            }
        }
        if (sq) sq_store(part, sq, u, wr, wc, fr, fq);
    }
};

template <bool RS_IS_SQ, bool FP8OUT = false, bool ACCI8 = false> struct EpiSwiGLU {
    bf16_t* out; int ldo; const float* rs; float ascale; const float* wmax;
    DI void operator()(const Acc& acc, const Unit& u, int wr, int wc, int fr, int fq) const {
        const int lr0 = wr * 64 + fr;
        f32x4 dq0[2], dq1[2];
        if constexpr (ACCI8) { const int c0 = u.pn * HALF + wc * 32 + 8 * fq;
#pragma unroll
            for (int n = 0; n < 2; ++n) { dq0[n] = *(const f32x4*)(wmax + c0 + 4 * n) * (1.0f / 127.0f); dq1[n] = *(const f32x4*)(wmax + FF + c0 + 4 * n) * (1.0f / 127.0f); } }
        float rvs[2][4];
#pragma unroll
        for (int ai = 0; ai < 2; ++ai)
#pragma unroll
            for (int m = 0; m < 4; ++m) { const int lr = lr0 + ai * HALF + m * 16; rvs[ai][m] = (RS_IS_SQ ? sq_rstd(rs, u.arow + lr) : rs[u.arow + lr]) * ascale; }
#pragma unroll
        for (int ai = 0; ai < 2; ++ai)
#pragma unroll
            for (int m = 0; m < 4; ++m) {
                const int lr = lr0 + ai * HALF + m * 16;
                const float rv = rvs[ai][m];
                const float rvo = FP8OUT ? rv * S8_ACT : rv, rvn = rv * -1.4426950408889634f;
                float gv[8];
#pragma unroll
                for (int n = 0; n < 2; ++n)
#pragma unroll
                    for (int e2 = 0; e2 < 2; ++e2) {
                        f32x2 x0 = {acc[ai][0][m][n][2 * e2], acc[ai][0][m][n][2 * e2 + 1]}, x1 = {acc[ai][1][m][n][2 * e2], acc[ai][1][m][n][2 * e2 + 1]};
                        if constexpr (ACCI8) { x0 = (f32x2){(float)__float_as_int(x0.x) * dq0[n][2 * e2], (float)__float_as_int(x0.y) * dq0[n][2 * e2 + 1]};
                                               x1 = (f32x2){(float)__float_as_int(x1.x) * dq1[n][2 * e2], (float)__float_as_int(x1.y) * dq1[n][2 * e2 + 1]}; }
                        const f32x2 t = x0 * rvn, ab = (x0 * rvo) * (x1 * rv);
                        f32x2 d; d.x = fexp2(t.x); d.y = fexp2(t.y); d = d + 1.0f;
                        f32x2 r; r.x = frcp(d.x); r.y = frcp(d.y);
                        const f32x2 g = ab * r;
                        gv[n * 4 + 2 * e2] = g.x; gv[n * 4 + 2 * e2 + 1] = g.y;
                    }
                if constexpr (FP8OUT) {
                    u32x2 w; w.x = pk4_fp8(gv[0], gv[1], gv[2], gv[3]); w.y = pk4_fp8(gv[4], gv[5], gv[6], gv[7]);
                    *(u32x2*)((unsigned char*)out + (size_t)(u.pm * BM + lr) * ldo + u.pn * HALF + wc * 32 + 8 * fq) = w;
                } else {
                    u32x4 w; w.x = pk2(gv[0], gv[1]); w.y = pk2(gv[2], gv[3]); w.z = pk2(gv[4], gv[5]); w.w = pk2(gv[6], gv[7]);
                    *(u32x4*)(out + (size_t)(u.pm * BM + lr) * ldo + u.pn * HALF + wc * 32 + 8 * fq) = w;
                }
            }
    }
};

template <bool I8COPY = false> struct EpiPLE {
    const bf16_t* hin; const bf16_t* pp; bf16_t* hout; float* sqout; const float* sqin; LAS float* part; unsigned char* h8;
    DI void operator()(const Acc& acc, const Unit& u, int wr, int wc, int fr, int fq) const {
        const int row0 = u.pm * BM + wr * 64 + fr, col0 = u.pn * BM + wc * 32 + 8 * fq;
#pragma unroll
        for (int ai = 0; ai < 2; ++ai) {
            u32x4 pws[4][2], hws[4][2]; float rvs[4];
#pragma unroll
            for (int m = 0; m < 4; ++m) { const int row = row0 + ai * HALF + m * 16; const size_t base = (size_t)row * D + col0; rvs[m] = sq_rstd(sqin, row);
#pragma unroll
                for (int bj = 0; bj < 2; ++bj) { pws[m][bj] = *(const u32x4*)(pp + base + bj * HALF); hws[m][bj] = *(const u32x4*)(hin + base + bj * HALF); } }
#pragma unroll
            for (int m = 0; m < 4; ++m) {
                const int row = row0 + ai * HALF + m * 16; const size_t base = (size_t)row * D + col0; float ss = 0.f;
                const float rv = rvs[m];
#pragma unroll
                for (int bj = 0; bj < 2; ++bj) {
                    const u32x4 pw = pws[m][bj], hw = hws[m][bj];
                    f32x4 a = (f32x4){bf_lo(hw.x), bf_hi(hw.x), bf_lo(hw.y), bf_hi(hw.y)}, b = (f32x4){bf_lo(hw.z), bf_hi(hw.z), bf_lo(hw.w), bf_hi(hw.w)};
                    const f32x4 g0 = acc[ai][bj][m][0] * rv, g1 = acc[ai][bj][m][1] * rv;
                    a[0] += sigmoidf_(g0[0]) * bf_lo(pw.x); a[1] += sigmoidf_(g0[1]) * bf_hi(pw.x); a[2] += sigmoidf_(g0[2]) * bf_lo(pw.y); a[3] += sigmoidf_(g0[3]) * bf_hi(pw.y);
                    b[0] += sigmoidf_(g1[0]) * bf_lo(pw.z); b[1] += sigmoidf_(g1[1]) * bf_hi(pw.z); b[2] += sigmoidf_(g1[2]) * bf_lo(pw.w); b[3] += sigmoidf_(g1[3]) * bf_hi(pw.w);
                    { u32x4 w; w.x = pk2(a[0], a[1]); w.y = pk2(a[2], a[3]); w.z = pk2(b[0], b[1]); w.w = pk2(b[2], b[3]); *(u32x4*)(hout + base + bj * HALF) = w; }
                    if (h8) { if constexpr (I8COPY) *(u32x2*)(h8 + base + bj * HALF) = (u32x2){pk4_i8(a[0] * SI8_H3, a[1] * SI8_H3, a[2] * SI8_H3, a[3] * SI8_H3), pk4_i8(b[0] * SI8_H3, b[1] * SI8_H3, b[2] * SI8_H3, b[3] * SI8_H3)};
                              else *(u32x2*)(h8 + base + bj * HALF) = (u32x2){pk4_fp8(a[0] * S8_H, a[1] * S8_H, a[2] * S8_H, a[3] * S8_H), pk4_fp8(b[0] * S8_H, b[1] * S8_H, b[2] * S8_H, b[3] * S8_H)}; }
                    ss += (a[0] * a[0] + a[1] * a[1]) + (a[2] * a[2] + a[3] * a[3]) + (b[0] * b[0] + b[1] * b[1]) + (b[2] * b[2] + b[3] * b[3]);
                }
                ss += __shfl_xor(ss, 16); ss += __shfl_xor(ss, 32); if (fq == 0) part[(wr * 64 + fr + ai * HALF + m * 16) * 4 + wc] = ss;
            }
        }
        sq_store(part, sqout, u, wr, wc, fr, fq);
    }
};

DI f32x4 cvt4i(const f32x4& v) { return (f32x4){(float)__float_as_int(v[0]), (float)__float_as_int(v[1]), (float)__float_as_int(v[2]), (float)__float_as_int(v[3])}; }
template <bool ISK, bool ACCI8 = false> struct EpiQK {
    bf16_t* q; unsigned char* q8; unsigned char* k8; const float* sqin; const float* cs; const float* sn; float* km; const float* wmax; float ascale;
    DI void operator()(Acc& acc, const Unit& u, int wr, int wc, int fr, int fq) const {
        constexpr bool isk = ISK; unsigned char* dst8 = isk ? k8 : q8; const int pnl = u.pn;
        const int row0 = u.pm * BM + wr * 64 + fr, col0 = pnl * BM + wc * 32 + 8 * fq;
        f32x4 csum[2][2];
#pragma unroll
        for (int bj = 0; bj < 2; ++bj)
#pragma unroll
            for (int n = 0; n < 2; ++n) csum[bj][n] = (f32x4){0.f, 0.f, 0.f, 0.f};
        float rvs[2][4];
#pragma unroll
        for (int ai = 0; ai < 2; ++ai)
#pragma unroll
            for (int m = 0; m < 4; ++m) rvs[ai][m] = sq_rstd(sqin, row0 + ai * HALF + m * 16) * ascale;
        if constexpr (ACCI8) {
#pragma unroll
            for (int bj = 0; bj < 2; ++bj)
#pragma unroll
                for (int n = 0; n < 2; ++n) { const f32x4 dq = *(const f32x4*)(wmax + col0 + bj * HALF + 4 * n) * (1.0f / 127.0f);
#pragma unroll
                    for (int ai = 0; ai < 2; ++ai)
#pragma unroll
                        for (int m = 0; m < 4; ++m) acc[ai][bj][m][n] = cvt4i(acc[ai][bj][m][n]) * (dq * rvs[ai][m]); } }
#define QK_ACC(n_) (ACCI8 ? acc[ai][bj][m][n_] : acc[ai][bj][m][n_] * rv)
        if (wc == 0) {
#pragma unroll
            for (int rp = 0; rp < 4; ++rp) {
                const int ai = rp >> 1, mb = 2 * (rp & 1);
                f32x4 c0s[2], c1s[2], s0s[2], s1s[2];
#pragma unroll
                for (int mm = 0; mm < 2; ++mm) { const int pos = (row0 + ai * HALF + (mb + mm) * 16) & (SEQ - 1); const float* cp = cs + pos * 16 + 8 * (fq & 1); const float* sp = sn + pos * 16 + 8 * (fq & 1);
                    c0s[mm] = *(const f32x4*)cp; c1s[mm] = *(const f32x4*)(cp + 4); s0s[mm] = *(const f32x4*)sp; s1s[mm] = *(const f32x4*)(sp + 4); }
#pragma unroll
                for (int mm = 0; mm < 2; ++mm) {
                    const int m = mb + mm; const size_t base = (size_t)(row0 + ai * HALF + m * 16) * D + col0; const float rv = rvs[ai][m];
#pragma unroll
                    for (int bj = 0; bj < 2; ++bj) {
                        f32x4 a = QK_ACC(0), b = QK_ACC(1), pa, pb;
#pragma unroll
                        for (int e = 0; e < 4; ++e) { pa[e] = __shfl_xor(a[e], 32); pb[e] = __shfl_xor(b[e], 32); }
                        if (fq < 2) { a = a * c0s[mm] - pa * s0s[mm]; b = b * c1s[mm] - pb * s1s[mm]; } else { a = a * c0s[mm] + pa * s0s[mm]; b = b * c1s[mm] + pb * s1s[mm]; }
                        if constexpr (!ISK) { u32x4 w; w.x = pk2(a[0], a[1]); w.y = pk2(a[2], a[3]); w.z = pk2(b[0], b[1]); w.w = pk2(b[2], b[3]); *(u32x4*)(q + base + bj * HALF) = w; }
                        *(u32x2*)(dst8 + base + bj * HALF) = (u32x2){pk4_fp8(a[0] * S8_QK, a[1] * S8_QK, a[2] * S8_QK, a[3] * S8_QK), pk4_fp8(b[0] * S8_QK, b[1] * S8_QK, b[2] * S8_QK, b[3] * S8_QK)};
                        if constexpr (ISK) { csum[bj][0] += a; csum[bj][1] += b; }
                    }
                }
            }
        } else {
#pragma unroll
            for (int ai = 0; ai < 2; ++ai)
#pragma unroll
                for (int m = 0; m < 4; ++m) {
                    const size_t base = (size_t)(row0 + ai * HALF + m * 16) * D + col0; const float rv = rvs[ai][m];
#pragma unroll
                    for (int bj = 0; bj < 2; ++bj) {
                        const f32x4 a = QK_ACC(0), b = QK_ACC(1);
                        if constexpr (!ISK) { u32x4 w; w.x = pk2(a[0], a[1]); w.y = pk2(a[2], a[3]); w.z = pk2(b[0], b[1]); w.w = pk2(b[2], b[3]); *(u32x4*)(q + base + bj * HALF) = w; }
                        *(u32x2*)(dst8 + base + bj * HALF) = (u32x2){pk4_fp8(a[0] * S8_QK, a[1] * S8_QK, a[2] * S8_QK, a[3] * S8_QK), pk4_fp8(b[0] * S8_QK, b[1] * S8_QK, b[2] * S8_QK, b[3] * S8_QK)};
                        if constexpr (ISK) { csum[bj][0] += a; csum[bj][1] += b; }
                    }
                }
        }
        if constexpr (ISK) {
            const int bb = u.pm >> 6, blk = u.pm & 63;
#pragma unroll
            for (int bj = 0; bj < 2; ++bj)
#pragma unroll
                for (int n = 0; n < 2; ++n)
#pragma unroll
                    for (int e = 0; e < 4; ++e) {
                        float v = csum[bj][n][e];
                        v += __shfl_xor(v, 1); v += __shfl_xor(v, 2); v += __shfl_xor(v, 4); v += __shfl_xor(v, 8);
                        if (fr == 0) unsafeAtomicAdd(km + (size_t)((bb * NH + pnl * 2 + bj) * NBLK + blk) * HD + wc * 32 + 8 * fq + 4 * n + e, v);
                    }
        }
#undef QK_ACC
    }
};

template <bool ACCI8 = false> struct EpiVT {
    unsigned char* vt; const float* sqin; const float* wmax; float ascale;
    DI void operator()(const Acc& acc, const Unit& u, int wr, int wc, int fr, int fq) const {
        const int row0 = u.pm * BM + wr * 64 + fr, col0 = u.pn * BM + wc * 32 + 8 * fq;
        f32x4 r0[2], r1[2];
#pragma unroll
        for (int bj = 0; bj < 2; ++bj)
#pragma unroll
            for (int e = 0; e < 4; ++e) { r0[bj][e] = sq_rstd(sqin, col0 + bj * HALF + e); r1[bj][e] = sq_rstd(sqin, col0 + bj * HALF + 4 + e); }
#pragma unroll
        for (int ai = 0; ai < 2; ++ai)
#pragma unroll
            for (int m = 0; m < 4; ++m) {
                const int row = row0 + ai * HALF + m * 16;
                const float dqr = ACCI8 ? wmax[row] * (S8_V * ascale / 127.0f) : S8_V * ascale;
#pragma unroll
                for (int bj = 0; bj < 2; ++bj) {
                    const f32x4 a = (ACCI8 ? cvt4i(acc[ai][bj][m][0]) : acc[ai][bj][m][0]) * (r0[bj] * dqr), b = (ACCI8 ? cvt4i(acc[ai][bj][m][1]) : acc[ai][bj][m][1]) * (r1[bj] * dqr);
                    *(u32x2*)(vt + (size_t)row * T + col0 + bj * HALF) = (u32x2){pk4_fp8(a[0], a[1], a[2], a[3]), pk4_fp8(b[0], b[1], b[2], b[3])};
                }
            }
    }
};

struct EpiPP {
    bf16_t* out;
    DI void operator()(const Acc& acc, const Unit& u, int wr, int wc, int fr, int fq) const {
        const int row0 = u.pm * BM + wr * 64 + fr, col0 = u.pn * BM + wc * 32 + 8 * fq;
#pragma unroll
        for (int ai = 0; ai < 2; ++ai)
#pragma unroll
            for (int m = 0; m < 4; ++m) {
                const size_t base = (size_t)(row0 + ai * HALF + m * 16) * D + col0;
#pragma unroll
                for (int bj = 0; bj < 2; ++bj) { const f32x4 a = acc[ai][bj][m][0], b = acc[ai][bj][m][1];
                    u32x4 w; w.x = pk2(a[0], a[1]); w.y = pk2(a[2], a[3]); w.z = pk2(b[0], b[1]); w.w = pk2(b[2], b[3]);
                    *(u32x4*)(out + base + bj * HALF) = w; }
            }
    }
};

struct EpiMoE2 {
    const int* dst; const float* gate; bf16_t* y1; bf16_t* y2; float gs;
    DI void operator()(const Acc& acc, const Unit& u, int wr, int wc, int fr, int fq) const {
        const int s0 = u.pm * BM + wr * 64 + fr, col0 = u.pn * BM + wc * 32 + 8 * fq;
        int ds[2][4]; float gvs[2][4];
#pragma unroll
        for (int ai = 0; ai < 2; ++ai)
#pragma unroll
            for (int m = 0; m < 4; ++m) { const int slot = s0 + ai * HALF + m * 16; ds[ai][m] = dst[slot]; gvs[ai][m] = gate[slot] * gs; }
#pragma unroll
        for (int ai = 0; ai < 2; ++ai)
#pragma unroll
            for (int m = 0; m < 4; ++m) {
                const int d = ds[ai][m]; const float gv = gvs[ai][m];
                if (d >= 0) {
                    bf16_t* yb = ((d & 1) ? y2 : y1) + (size_t)(d >> 1) * D + col0;
#pragma unroll
                    for (int bj = 0; bj < 2; ++bj) { const f32x4 a = acc[ai][bj][m][0] * gv, b = acc[ai][bj][m][1] * gv;
                        u32x4 w; w.x = pk2(a[0], a[1]); w.y = pk2(a[2], a[3]); w.z = pk2(b[0], b[1]); w.w = pk2(b[2], b[3]);
                        *(u32x4*)(yb + bj * HALF) = w; }
                }
            }
    }
};
}

struct Args { const float* in[23]; float* out; unsigned char* ws; int ph_lo, ph_hi; };
struct Frame {
    LAS unsigned char* lds; int G, wv;
    float* out; unsigned char* ws;
};
#define PHASE_IDS int wvv_ = F.wv; asm volatile("" : "+s"(wvv_)); int tid_ = wvv_ * 64 + lane_id(); asm volatile("" : "+v"(tid_)); const int lane_ = tid_ & 63, wave_ = __builtin_amdgcn_readfirstlane(tid_ >> 6); (void)lane_; (void)wave_
DI const float* inp(int i) { const char* ka = (const char*)__builtin_amdgcn_kernarg_segment_ptr(); asm volatile("" : "+s"(ka)); return *(const float* const*)(ka + 8 * i); }
enum { I_X = 0, I_P, I_POOL_NORM, I_POOL_W, I_POOL_SCALE, I_KV_NORM, I_WK, I_WV, I_ATTN_NORM, I_WQ, I_WO, I_FFN_NORM, I_W1, I_W3, I_W2, I_ROUTER, I_EW1, I_EW3, I_EW2,
       I_PLE_NORM, I_PLE_GATE, I_PLE_PROJ, I_FINAL_NORM };

DI void conv_matrix(const Frame& F, const float* src, int Ks, int Ns, bf16_t* dst, int rbase, int mode, const float* gain, const float* cscale, int& rot) {
    PHASE_IDS;
    LAS bf16_t* tile = (LAS bf16_t*)F.lds;
    const int ntk = Ks >> 6, ntn = Ns >> 6, ntiles = ntk * ntn;
    const int ty = tid_ >> 4, tx = tid_ & 15, wn = tid_ >> 3, wk = tid_ & 7;
    int first = (int)blockIdx.x - rot; if (first < 0) first += F.G;
    for (int tl0 = first; tl0 < ntiles; tl0 += 4 * F.G) {
        f32x4 v[4][2];
#pragma unroll
        for (int q = 0; q < 4; ++q) { const int tl = (tl0 + q * F.G < ntiles) ? tl0 + q * F.G : tl0; const int k0 = (tl % ntk) << 6, n0 = (tl / ntk) << 6;
#pragma unroll
            for (int i = 0; i < 2; ++i) v[q][i] = *(const f32x4*)(src + (size_t)(k0 + ty + 32 * i) * Ns + n0 + 4 * tx); }
#pragma unroll
        for (int q = 0; q < 4; ++q) { const int tl = (tl0 + q * F.G < ntiles) ? tl0 + q * F.G : tl0; const int k0 = (tl % ntk) << 6, n0 = (tl / ntk) << 6;
#pragma unroll
            for (int i = 0; i < 2; ++i) { const int k = ty + 32 * i; f32x4 x = v[q][i];
                if (gain) x = x * gain[k0 + k];
                if (cscale) x = x * *(const f32x4*)(cscale + n0 + 4 * tx);
#pragma unroll
                for (int e = 0; e < 4; ++e) tile[q * 4608 + (4 * tx + e) * 72 + k] = (bf16_t)(pk2(x[e], 0.f) & 0xffffu); } }
        __syncthreads();
#pragma unroll
        for (int q = 0; q < 4; ++q) if (tl0 + q * F.G < ntiles) { const int tl = tl0 + q * F.G; const int k0 = (tl % ntk) << 6, n0 = (tl / ntk) << 6;
            const int n = n0 + wn; const int drow = (mode == 0) ? rbase + n : rbase + (n >> 7) * 256 + (mode - 1) * 128 + (n & 127);
            *(u32x4*)(dst + (size_t)drow * Ks + k0 + wk * 8) = *(const LAS u32x4*)(tile + q * 4608 + wn * 72 + wk * 8); }
        __syncthreads();
    }
    rot = (rot + ntiles) % F.G;
}

DI void conv_matrix_fp8(const Frame& F, const float* src, int Ks, int Ns, unsigned char* dst, int rbase, int mode, const float* gain, float scale, int& rot, const float* colmax = nullptr) {
    PHASE_IDS;
    LAS unsigned char* tile = F.lds;
    const int ntk = Ks >> 7, ntn = Ns >> 6, ntiles = ntk * ntn;
    const int ty = tid_ >> 4, tx = tid_ & 15, wn = tid_ >> 3, wk = tid_ & 7;
    int first = (int)blockIdx.x - rot; if (first < 0) first += F.G;
    for (int tl = first; tl < ntiles; tl += 2 * F.G) {
        const int tl2 = tl + F.G; const bool two = tl2 < ntiles;
        const int k0 = (tl % ntk) << 7, n0 = (tl / ntk) << 6, k1 = two ? (tl2 % ntk) << 7 : k0, n1 = two ? (tl2 / ntk) << 6 : n0;
        f32x4 v[4], w[4];
#pragma unroll
        for (int i = 0; i < 4; ++i) { const int k = 4 * ty + i; v[i] = *(const f32x4*)(src + (size_t)(k0 + k) * Ns + n0 + 4 * tx); w[i] = *(const f32x4*)(src + (size_t)(k1 + k) * Ns + n1 + 4 * tx); }
#pragma unroll
        for (int i = 0; i < 4; ++i) { const int k = 4 * ty + i; v[i] = v[i] * (gain ? gain[k0 + k] * scale : scale); w[i] = w[i] * (gain ? gain[k1 + k] * scale : scale); }
        if (colmax) {
            f32x4 c0 = *(const f32x4*)(colmax + n0 + 4 * tx), c1 = *(const f32x4*)(colmax + n1 + 4 * tx);
#pragma unroll
            for (int e = 0; e < 4; ++e) { c0[e] = 127.0f * frcp(fmaxf(c0[e], 1e-30f)); c1[e] = 127.0f * frcp(fmaxf(c1[e], 1e-30f)); }
#pragma unroll
            for (int i = 0; i < 4; ++i) { v[i] = v[i] * c0; w[i] = w[i] * c1; }
#pragma unroll
            for (int e = 0; e < 4; ++e) { *(LAS unsigned*)(tile + (4 * tx + e) * 144 + 4 * ty) = pk4_i8(v[0][e], v[1][e], v[2][e], v[3][e]);
                                          *(LAS unsigned*)(tile + 9216 + (4 * tx + e) * 144 + 4 * ty) = pk4_i8(w[0][e], w[1][e], w[2][e], w[3][e]); }
        } else {
#pragma unroll
        for (int e = 0; e < 4; ++e) { *(LAS unsigned*)(tile + (4 * tx + e) * 144 + 4 * ty) = pk4_fp8(v[0][e], v[1][e], v[2][e], v[3][e]);
                                      *(LAS unsigned*)(tile + 9216 + (4 * tx + e) * 144 + 4 * ty) = pk4_fp8(w[0][e], w[1][e], w[2][e], w[3][e]); }
        }
        __syncthreads();
        { const int n = n0 + wn; const int drow = (mode == 0) ? rbase + n : rbase + (n >> 7) * 256 + (mode - 1) * 128 + (n & 127);
          *(u32x4*)(dst + (size_t)drow * Ks + k0 + wk * 16) = *(const LAS u32x4*)(tile + wn * 144 + wk * 16); }
        if (two) { const int n = n1 + wn; const int drow = (mode == 0) ? rbase + n : rbase + (n >> 7) * 256 + (mode - 1) * 128 + (n & 127);
          *(u32x4*)(dst + (size_t)drow * Ks + k1 + wk * 16) = *(const LAS u32x4*)(tile + 9216 + wn * 144 + wk * 16); }
        __syncthreads();
    }
    rot = (rot + ntiles) % F.G;
}

DI void sincos_acc(float ang, float& c, float& s) {
    const double a = (double)ang;
    const double q = __builtin_rint(a * 0.63661977236758134308);
    double r = __builtin_fma(-q, 1.57079632679489655800e+00, a); r = __builtin_fma(-q, 6.12323399573676603587e-17, r);
    const double r2 = r * r;
    double sp = -7.6471637318198164759e-13; sp = sp * r2 + 1.6059043836821614599e-10; sp = sp * r2 - 2.5052108385441718775e-08; sp = sp * r2 + 2.7557319223985890653e-06;
    sp = sp * r2 - 1.9841269841269841270e-04; sp = sp * r2 + 8.3333333333333333333e-03; sp = sp * r2 - 1.6666666666666666667e-01; const double sr = r + r * r2 * sp;
    double cp = 4.7794773323873852974e-14; cp = cp * r2 - 1.1470745597729724714e-11; cp = cp * r2 + 2.0876756987868098979e-09; cp = cp * r2 - 2.7557319223985890653e-07;
    cp = cp * r2 + 2.4801587301587301587e-05; cp = cp * r2 - 1.3888888888888888889e-03; cp = cp * r2 + 4.1666666666666666667e-02; cp = cp * r2 - 0.5; const double cr = 1.0 + r2 * cp;
    const int qi = (int)((long long)q & 3);
    const double sv = (qi == 0) ? sr : (qi == 1) ? cr : (qi == 2) ? -sr : -cr;
    const double cv = (qi == 0) ? cr : (qi == 1) ? -sr : (qi == 2) ? -cr : sr;
    c = (float)cv; s = (float)sv;
}

DI void colmax_pass(const Frame& F, const float* src, int Ns, const float* gain, unsigned* wmax, int& rot) {
    PHASE_IDS;
    const int njobs = (Ns >> 8) * 32;
    int first = (int)blockIdx.x - rot; if (first < 0) first += F.G;
    for (int job = first; job < njobs; job += F.G) {
        const int cb = job >> 5, rb = job & 31;
        const int n = cb * 256 + (tid_ & 255), r0 = rb * 32 + (tid_ >> 8) * 16;
        float mx = 0.f;
#pragma unroll
        for (int i = 0; i < 16; ++i) mx = fmaxf(mx, fabsf(src[(size_t)(r0 + i) * Ns + n] * gain[r0 + i]));
        atomicMax(wmax + n, __float_as_uint(mx));
    }
    rot = (rot + njobs) % F.G;
}

DI void p0_prologue(const Frame& F) {
    PHASE_IDS;
    unsigned char* ws = F.ws;
    int rot = 0;
    for (int g = 0; g < 4; ++g) conv_matrix(F, inp(I_POOL_W) + (size_t)g * 65536, 256, 256, (bf16_t*)(ws + WO_POOL), g * 256, 0, nullptr, inp(I_POOL_SCALE) + g * 256, rot);
    if (FP8_FFN0 & 1) { conv_matrix_fp8(F, inp(I_W1), D, FF, ws + WO_F13, 0, 1, inp(I_FFN_NORM), S8_W13, rot); conv_matrix_fp8(F, inp(I_W3), D, FF, ws + WO_F13, 0, 2, inp(I_FFN_NORM), S8_W13, rot); }
    else if (I8_UP) {
        colmax_pass(F, inp(I_W1), FF, inp(I_FFN_NORM), (unsigned*)(ws + ZO_WMAX), rot);
        colmax_pass(F, inp(I_W3), FF, inp(I_FFN_NORM), (unsigned*)(ws + ZO_WMAX) + FF, rot);
    }
    else { conv_matrix(F, inp(I_W1), D, FF, (bf16_t*)(ws + WO_F13), 0, 1, inp(I_FFN_NORM), nullptr, rot); conv_matrix(F, inp(I_W3), D, FF, (bf16_t*)(ws + WO_F13), 0, 2, inp(I_FFN_NORM), nullptr, rot); }
    if (FP8_FFN0 & 2) conv_matrix_fp8(F, inp(I_W2), FF, D, ws + WO_F2, 0, 0, nullptr, S8_WF2, rot);
    else conv_matrix(F, inp(I_W2), FF, D, (bf16_t*)(ws + WO_F2), 0, 0, nullptr, nullptr, rot);
    conv_matrix(F, inp(I_PLE_GATE), D, D, (bf16_t*)(ws + WO_G0), 0, 0, inp(I_PLE_NORM), nullptr, rot);
    conv_matrix(F, inp(I_PLE_GATE) + (size_t)D * D, D, D, (bf16_t*)(ws + WO_G1), 0, 0, inp(I_PLE_NORM) + D, nullptr, rot);
    conv_matrix(F, inp(I_PLE_PROJ), PD, D, (bf16_t*)(ws + WO_P0), 0, 0, nullptr, nullptr, rot);
    conv_matrix(F, inp(I_PLE_PROJ) + (size_t)PD * D, PD, D, (bf16_t*)(ws + WO_P1), 0, 0, nullptr, nullptr, rot);
    if (I8_QKV) {
        colmax_pass(F, inp(I_WQ), D, inp(I_ATTN_NORM), (unsigned*)(ws + ZO_WMQKV), rot);
        colmax_pass(F, inp(I_WK), D, inp(I_KV_NORM), (unsigned*)(ws + ZO_WMQKV) + D, rot);
        colmax_pass(F, inp(I_WV), D, inp(I_KV_NORM), (unsigned*)(ws + ZO_WMQKV) + 2 * D, rot);
    } else {
    conv_matrix(F, inp(I_WQ), D, D, (bf16_t*)(ws + WO_QK), 0, 0, inp(I_ATTN_NORM), nullptr, rot);
    conv_matrix(F, inp(I_WK), D, D, (bf16_t*)(ws + WO_QK), D, 0, inp(I_KV_NORM), nullptr, rot);
    conv_matrix_fp8(F, inp(I_WV), D, D, ws + WO_V, 0, 0, inp(I_KV_NORM), S8_WKV, rot);
    }
    conv_matrix(F, inp(I_WO), D, D, (bf16_t*)(ws + WO_O), 0, 0, nullptr, nullptr, rot);
    {
        const float* p = inp(I_P); bf16_t* pb = (bf16_t*)(ws + WS_PB);
        const size_t n8 = (size_t)2 * T * PD / 8;
        for (size_t i = (size_t)blockIdx.x * 512 + tid_; i < n8; i += (size_t)F.G * 512) {
            const f32x4 a = *(const f32x4*)(p + i * 8), b = *(const f32x4*)(p + i * 8 + 4);
            u32x4 w; w.x = pk2(a[0], a[1]); w.y = pk2(a[2], a[3]); w.z = pk2(b[0], b[1]); w.w = pk2(b[2], b[3]);
            *(u32x4*)(pb + i * 8) = w;
        }
    }
    {
        float* cs = (float*)(ws + WS_ROPE); float* sn = cs + SEQ * 16;
        for (int i = blockIdx.x * 512 + tid_; i < SEQ * 16; i += F.G * 512) {
            const int pos = i >> 4, f = i & 15;
            const float inv = __uint_as_float(f == 0 ? 0x3f800000u : 0u) + ((f == 1) ? 4.403665960e-01f : (f == 2) ? 1.939227432e-01f : (f == 3) ? 8.539710194e-02f : (f == 4) ? 3.760603070e-02f :
                (f == 5) ? 1.656044088e-02f : (f == 6) ? 7.292664610e-03f : (f == 7) ? 3.211446106e-03f : (f == 8) ? 1.414213562e-03f : (f == 9) ? 6.227724371e-04f : (f == 10) ? 2.742481884e-04f :
                (f == 11) ? 1.207697351e-04f : (f == 12) ? 5.318295734e-05f : (f == 13) ? 2.341999971e-05f : (f == 14) ? 1.031338525e-05f : (f == 15) ? 4.541670478e-06f : 0.f);
            const float ang = (float)pos * inv;
            float c, s; sincos_acc(ang, c, s); cs[i] = c; sn[i] = s;
        }
    }
    {
        LAS float* rsl = (LAS float*)(F.lds + 65536);
        const float* x = inp(I_X); const float* pg = inp(I_POOL_NORM);
        bf16_t* pooled = (bf16_t*)(ws + O_POOLED);
        for (int tile = blockIdx.x; tile < T / 128; tile += F.G) {
            const int s0 = tile * 128, p0 = s0 & (SEQ - 1), halo = p0 < 15 ? p0 : 15;
            for (int r0 = wave_; r0 < halo + 128; r0 += 32) {
                f32x4 v[4][4];
#pragma unroll
                for (int q = 0; q < 4; ++q) { const int r = r0 + 8 * q; const int rc = r < halo + 128 ? r : halo + 127;
                    const float* xp = x + (size_t)(s0 - halo + rc) * D + lane_ * 4;
#pragma unroll
                    for (int j = 0; j < 4; ++j) v[q][j] = *(const f32x4*)(xp + j * 256); }
                float ss[4];
#pragma unroll
                for (int q = 0; q < 4; ++q) { float a = 0.f;
#pragma unroll
                    for (int j = 0; j < 4; ++j) a += (v[q][j][0] * v[q][j][0] + v[q][j][1] * v[q][j][1]) + (v[q][j][2] * v[q][j][2] + v[q][j][3] * v[q][j][3]);
                    ss[q] = a; }
#pragma unroll
                for (int q = 0; q < 4; ++q) ss[q] = wave_sum(ss[q]);
#pragma unroll
                for (int q = 0; q < 4; ++q) { const int r = r0 + 8 * q; if (lane_ == 0 && r < halo + 128) rsl[15 - halo + r] = __builtin_amdgcn_rsqf(ss[q] * (1.0f / D) + EPS); }
            }
            __syncthreads();
            {
                const int g = wave_ & 3, half = wave_ >> 2, W = 2 << g;
                const int cb = g * 256 + lane_ * 4;
                const f32x4 gn = *(const f32x4*)(pg + cb);
                const int ss0 = s0 + half * 64, ps0 = p0 + half * 64;
                const float* xc = x + cb;
                f32x4 sum = (f32x4){0.f, 0.f, 0.f, 0.f};
                for (int i = 1; i < W; ++i) if (ps0 - i >= 0) sum += *(const f32x4*)(xc + (size_t)(ss0 - i) * D) * (rsl[ss0 - i - s0 + 15] * gn);
                bf16_t* op = pooled + ((size_t)g * T + ss0) * 256 + lane_ * 4;
#pragma unroll 1
                for (int c8 = 0; c8 < 8; ++c8) {
                    f32x4 cur[8], old[8];
#pragma unroll
                    for (int i = 0; i < 8; ++i) { const int r = c8 * 8 + i, s = ss0 + r, pos = ps0 + r;
                        cur[i] = *(const f32x4*)(xc + (size_t)s * D);
                        const int so = (pos - W + 1 >= 0) ? s - W + 1 : s;
                        old[i] = *(const f32x4*)(xc + (size_t)so * D); }
#pragma unroll
                    for (int i = 0; i < 8; ++i) { const int r = c8 * 8 + i, s = ss0 + r, pos = ps0 + r;
                        const f32x4 cv = cur[i] * (rsl[s - s0 + 15] * gn);
                        sum += cv;
                        const int cnt = (pos + 1 < W) ? pos + 1 : W;
                        const f32x4 o = sum * frcp((float)cnt) - cv;
                        u32x2 w; w.x = pk2(o[0], o[1]); w.y = pk2(o[2], o[3]);
                        *(u32x2*)(op + (size_t)r * 256) = w;
                        if (pos - W + 1 >= 0) sum -= old[i] * (rsl[s - W + 1 - s0 + 15] * gn); }
                }
            }
            __syncthreads();
        }
    }
}

DI void conv_moe_weights(const Frame& F) {
    unsigned char* ws = F.ws; int rot = 0;
    for (int e = 0; e < NE; ++e) {
        conv_matrix_fp8(F, inp(I_EW1) + (size_t)e * D * EFF, D, EFF, ws + O_WE13, e * 2 * EFF, 1, inp(I_FFN_NORM) + D, S8_W13, rot);
        conv_matrix_fp8(F, inp(I_EW3) + (size_t)e * D * EFF, D, EFF, ws + O_WE13, e * 2 * EFF, 2, inp(I_FFN_NORM) + D, S8_W13, rot);
        conv_matrix_fp8(F, inp(I_EW2) + (size_t)e * EFF * D, EFF, D, ws + O_WE2, e * D, 0, nullptr, S8_W2, rot);
    }
}

DI bool sel_better(float v, int i, float w, int k) { return (v > w) || (v == w && i < k); }
DI void sel_insert(float v, int i, float& v0, int& i0, float& v1, int& i1, float& v2, int& i2) {
    const bool b0 = sel_better(v, i, v0, i0), b1 = sel_better(v, i, v1, i1), b2 = sel_better(v, i, v2, i2);
    const float n2 = b1 ? v1 : (b2 ? v : v2), n1 = b0 ? v0 : (b1 ? v : v1), n0 = b0 ? v : v0;
    const int m2 = b1 ? i1 : (b2 ? i : i2), m1 = b0 ? i0 : (b1 ? i : i1), m0 = b0 ? i : i0;
    v0 = n0; v1 = n1; v2 = n2; i0 = m0; i1 = m1; i2 = m2;
}
DI void moba_select(const Frame& F) {
    PHASE_IDS;
    unsigned char* ws = F.ws;
    const bf16_t* Q = (const bf16_t*)(ws + O_Q); const float* KM = (const float*)(ws + ZO_KM);
    unsigned* LCNT = (unsigned*)(ws + ZO_LCNT); unsigned short* LIST = (unsigned short*)(ws + O_LIST);
    LAS bf16_t* kh = (LAS bf16_t*)F.lds;
    LAS bf16_t* kl = kh + 64 * 136;
    LAS unsigned* lcnt = (LAS unsigned*)(F.lds + 49152); LAS unsigned* lbase = lcnt + 64;
    const int fr = lane_ & 15, fq = lane_ >> 4;
    for (int unit = blockIdx.x; unit < BATCH * NH * 32; unit += F.G) {
        const int b = unit >> 8, h = (unit >> 5) & 7, c = b ? 31 - (unit & 31) : (unit & 31);
        const int jmax = 2 * c + 1;
        for (int idx = tid_; idx < 64 * 32; idx += 512) {
            const int n = idx >> 5, d4 = idx & 31;
            f32x4 v = (f32x4){0.f, 0.f, 0.f, 0.f};
            if (n < jmax) v = *(const f32x4*)(KM + (size_t)((b * NH + h) * NBLK + n) * HD + d4 * 4) * (1.0f / 256.0f);
            unsigned hi[4], lo[4];
#pragma unroll
            for (int e = 0; e < 4; ++e) { hi[e] = pk2(v[e], 0.f) & 0xffffu; lo[e] = pk2(v[e] - __uint_as_float(hi[e] << 16), 0.f) & 0xffffu; }
            *(LAS u32x2*)(kh + n * 136 + d4 * 4) = (u32x2){hi[0] | (hi[1] << 16), hi[2] | (hi[3] << 16)};
            *(LAS u32x2*)(kl + n * 136 + d4 * 4) = (u32x2){lo[0] | (lo[1] << 16), lo[2] | (lo[3] << 16)};
        }
        if (tid_ < 64) lcnt[tid_] = 0u;
        __syncthreads();
        int selv[4]; unsigned lpv[4];
#pragma unroll
        for (int gi = 0; gi < 4; ++gi) {
            const int s = c * 512 + (wave_ * 4 + gi) * 16 + fr;
            const int j = (c * 512 + (wave_ * 4 + gi) * 16) >> 8;
            const bf16_t* qp = Q + ((size_t)(b * SEQ + s)) * D + h * HD + 8 * fq;
            bf16x8 qf[4];
#pragma unroll
            for (int ks = 0; ks < 4; ++ks) qf[ks] = *(const bf16x8*)(qp + 32 * ks);
            f32x4 acc[4];
#pragma unroll
            for (int nt = 0; nt < 4; ++nt) { acc[nt] = (f32x4){0.f, 0.f, 0.f, 0.f};
#pragma unroll
                for (int ks = 0; ks < 4; ++ks) {
                    const bf16x8 ah = *(const LAS bf16x8*)(kh + (16 * nt + fr) * 136 + 32 * ks + 8 * fq), al = *(const LAS bf16x8*)(kl + (16 * nt + fr) * 136 + 32 * ks + 8 * fq);
                    acc[nt] = __builtin_amdgcn_mfma_f32_16x16x32_bf16(ah, qf[ks], acc[nt], 0, 0, 0);
                    acc[nt] = __builtin_amdgcn_mfma_f32_16x16x32_bf16(al, qf[ks], acc[nt], 0, 0, 0);
                } }
            float v0 = -3.0e38f, v1 = -3.0e38f, v2 = -3.0e38f; int i0 = 1000, i1 = 1001, i2 = 1002;
#pragma unroll
            for (int nt = 0; nt < 4; ++nt)
#pragma unroll
                for (int e = 0; e < 4; ++e) { const int n = 16 * nt + 4 * fq + e; if (n < j) sel_insert(acc[nt][e], n, v0, i0, v1, i1, v2, i2); }
#pragma unroll
            for (int sti = 0; sti < 2; ++sti) { const int st = 16 << sti;
                const float w0 = __shfl_xor(v0, st), w1 = __shfl_xor(v1, st), w2 = __shfl_xor(v2, st);
                const int k0 = __shfl_xor(i0, st), k1 = __shfl_xor(i1, st), k2 = __shfl_xor(i2, st);
                sel_insert(w0, k0, v0, i0, v1, i1, v2, i2); sel_insert(w1, k1, v0, i0, v1, i1, v2, i2); sel_insert(w2, k2, v0, i0, v1, i1, v2, i2);
            }
            const int nsel = j < 3 ? j : 3;
            const int mine = (fq == 0) ? i0 : (fq == 1) ? i1 : i2;
            selv[gi] = (fq < nsel) ? mine : -1; lpv[gi] = 0u;
            if (selv[gi] >= 0) lpv[gi] = lds_add(lcnt + selv[gi], 1u);
        }
        __syncthreads();
        if (tid_ < 64) { const unsigned cc = lcnt[tid_]; lbase[tid_] = cc ? atomicAdd(LCNT + (b * NH + h) * NBLK + tid_, cc) : 0u; }
        __syncthreads();
        { unsigned short* lb = LIST + (size_t)((b * NH + h) * NBLK) * SEQ;
#pragma unroll
          for (int gi = 0; gi < 4; ++gi) if (selv[gi] >= 0) { const int s = c * 512 + (wave_ * 4 + gi) * 16 + fr;
              lb[(size_t)selv[gi] * SEQ + lbase[selv[gi]] + lpv[gi]] = (unsigned short)((s << 2) | fq); } }
        __syncthreads();
    }
}

#define MFMA32(a, b, c) __builtin_amdgcn_mfma_f32_32x32x16_bf16((a), (b), (c), 0, 0, 0)
DI bf16x8 pack8(const f32x16& x, int s) {
    u32x4 p; p.x = pk2(x[8 * s], x[8 * s + 1]); p.y = pk2(x[8 * s + 2], x[8 * s + 3]); p.z = pk2(x[8 * s + 4], x[8 * s + 5]); p.w = pk2(x[8 * s + 6], x[8 * s + 7]);
    return __builtin_bit_cast(bf16x8, p);
}
DI void moba_partial(const Frame& F) {
    unsigned char* ws = F.ws;
    const unsigned char* Q8 = ws + O_Q8; const unsigned char* K8 = ws + O_K8; const unsigned char* VT8 = ws + O_VT8;
    const unsigned* LCNT = (const unsigned*)(ws + ZO_LCNT); const unsigned short* LIST0 = (const unsigned short*)(ws + O_LIST);
    unsigned char* PO = ws + O_PO; f32x2* ML = (f32x2*)(ws + O_ML);
    unsigned* qctr = (unsigned*)(ws + ZO_CNT) + 128;
    LAS int* pre = (LAS int*)(F.lds + TAB_OFF);
    LAS int* qslot = (LAS int*)(F.lds + MISC_OFF + 64);
    int wvv = F.wv; asm volatile("" : "+s"(wvv)); int tid = wvv * 64 + lane_id(); asm volatile("" : "+v"(tid));
    const int w = F.wv;
    int cur = 0;
#pragma unroll
    for (int q = 0; q < 2; ++q) { const int io = tid + 512 * q, bh = io & 15, nq = io >> 4; const int cnt = (int)LCNT[bh * NBLK + nq]; const int tiles = 1 + ((cnt + 255) >> 8); pre[io] = (tiles + ATT_C - 1) / ATT_C; }
    __syncthreads();
    for (int off = 1; off < 1024; off <<= 1) {
        int v[2];
#pragma unroll
        for (int q = 0; q < 2; ++q) { const int io = tid + 512 * q; v[q] = pre[cur * 1024 + io] + (io >= off ? pre[cur * 1024 + io - off] : 0); }
#pragma unroll
        for (int q = 0; q < 2; ++q) pre[(cur ^ 1) * 1024 + tid + 512 * q] = v[q];
        __syncthreads(); cur ^= 1; }
    const LAS int* pf = pre + cur * 1024;
    const int U = __builtin_amdgcn_readfirstlane(pf[1023]);
    for (;;) {
        if (tid == 0) *qslot = (int)__hip_atomic_fetch_add(qctr, 1u, __ATOMIC_RELAXED, __HIP_MEMORY_SCOPE_AGENT);
        __syncthreads();
        const int u = __builtin_amdgcn_readfirstlane(*qslot);
        if (u >= U) break;
        int lo = 0, hi = 1023;
        while (lo < hi) { const int mid = (lo + hi) >> 1; if (pf[mid] > u) hi = mid; else lo = mid + 1; }
        const int io = lo, chunk = u - (io ? pf[io - 1] : 0);
        const int h = io & 7, b = (io >> 3) & 1, n = io >> 4, item = (b * NH + h) * NBLK + n;
        const unsigned short* LIST = LIST0;
        const int cnt = (int)LCNT[item];
        const int ntile = 1 + ((cnt + 255) >> 8);
        const int tile0 = chunk * ATT_C, tile1 = (tile0 + ATT_C < ntile) ? tile0 + ATT_C : ntile;
        const size_t tbase = (size_t)b * SEQ + n * 256;
        asm volatile("" : "+v"(tid));
        const int lane = tid & 63, r = lane & 31, hh = lane >> 5;
        const int qi = 32 * w + r;
#pragma unroll
        for (int i = 0; i < 4; ++i) { const int p = tid + 512 * i, key = p >> 3, c = p & 7;
            const u32x4 v = *(const u32x4*)(K8 + (tbase + key) * D + h * HD + c * 16);
            *(LAS u32x4*)(F.lds + key * 128 + ((c ^ ((key >> 1) & 7)) << 4)) = v; }
#pragma unroll
        for (int i = 0; i < 4; ++i) { const int p = tid + 512 * i, d = p >> 4, j16 = p & 15, G = j16 >> 2, j = j16 & 3;
            const u32x4 v = *(const u32x4*)(VT8 + (size_t)(h * HD + d) * T + tbase + j16 * 16);
            const int pos0 = (j >> 1) * 16 + (j & 1) * 8;
            const int bo0 = G * 64 + pos0, bo1 = bo0 + 32;
            *(LAS u32x2*)(F.lds + 32768 + d * 256 + ((((bo0 >> 4) ^ (d & 15)) << 4) | (bo0 & 15))) = (u32x2){v.x, v.z};
            *(LAS u32x2*)(F.lds + 32768 + d * 256 + ((((bo1 >> 4) ^ (d & 15)) << 4) | (bo1 & 15))) = (u32x2){v.y, v.w}; }
        __syncthreads();
#define MFMA8Z(acc_, a_, b_) asm volatile("v_mfma_scale_f32_32x32x64_f8f6f4 %0, %1, %2, 0, %3, %3 op_sel_hi:[0,0,0]" : "=&v"(acc_) : "v"(a_), "v"(b_), "v"(one_e8m0))
#define MFMA8(acc_, a_, b_) asm volatile("v_mfma_scale_f32_32x32x64_f8f6f4 %0, %1, %2, %0, %3, %3 op_sel_hi:[0,0,0]" : "+v"(acc_) : "v"(a_), "v"(b_), "v"(one_e8m0))
#define MFMA_SETTLE() asm volatile("s_nop 7\n\ts_nop 7\n\ts_nop 7" ::: "memory")
        const int one_e8m0 = 0x7F7F7F7F;
#define ATT_ENTRY(t_) (((t_) == 0) ? (((n * 256 + qi) << 2) | 3) : (((t_) - 1) * 256 + qi < cnt ? (int)LIST[(size_t)item * SEQ + ((t_) - 1) * 256 + qi] : -1))
#define ATT_QLOAD(e_) do { const unsigned char* qp_ = Q8 + ((size_t)b * SEQ + (((e_) < 0 ? 0 : (e_)) >> 2)) * D + h * HD + 32 * hh; _Pragma("unroll") for (int mf = 0; mf < 2; ++mf) \
            qn[mf] = __builtin_shufflevector(*(const i32x4*)(qp_ + 64 * mf), *(const i32x4*)(qp_ + 64 * mf + 16), 0, 1, 2, 3, 4, 5, 6, 7); } while (0)
        i32x8 qn[2];
        int e_cur = ATT_ENTRY(tile0);
        ATT_QLOAD(e_cur);
        int e_nxt = (tile0 + 1 < tile1) ? ATT_ENTRY(tile0 + 1) : -1;
#pragma unroll 1
        for (int tile = tile0; tile < tile1; ++tile) {
        i32x8 qf[2];
        qf[0] = qn[0]; qf[1] = qn[1];
        const int e_this = e_cur;
        e_cur = e_nxt;
        if (tile + 1 < tile1) ATT_QLOAD(e_cur);
        e_nxt = (tile + 2 < tile1) ? ATT_ENTRY(tile + 2) : -1;
        const bool wave_active = (tile == 0) || ((tile - 1) * 256 + 32 * w < cnt);
        if (wave_active) {
            f32x16 o[4];
            float mrun = -__builtin_inff(), lrun = 0.f;
            const float sc = 0.08838834764831845f * 1.4426950408889634f * (1.0f / (S8_QK * S8_QK));
            const int nhalf = (tile == 0 && w < 4) ? 1 : 2;
            const int rq0 = (r >> 3) & 3, rl0 = r & 7;
#pragma unroll 1
            for (int hf = 0; hf < nhalf; ++hf) {
                int rl = rl0, rq = rq0; asm volatile("" : "+v"(rl), "+v"(rq));
                const int rr_ = (rq << 3) | rl;
                f32x16 x[4];
                {
                    const int ksw = (rr_ >> 1) & 7;
                    const LAS unsigned char* kl = F.lds + hf * 16384 + rr_ * 128;
#pragma unroll
                    for (int mf = 0; mf < 2; ++mf)
#pragma unroll
                        for (int kt = 0; kt < 4; ++kt) {
                            const i32x4 k0 = *(const LAS i32x4*)(kl + kt * 4096 + (((4 * mf + 2 * hh) ^ ksw) << 4)), k1 = *(const LAS i32x4*)(kl + kt * 4096 + (((4 * mf + 2 * hh + 1) ^ ksw) << 4));
                            const i32x8 kf = __builtin_shufflevector(k0, k1, 0, 1, 2, 3, 4, 5, 6, 7);
                            if (mf == 0) MFMA8Z(x[kt], kf, qf[0]); else MFMA8(x[kt], kf, qf[1]);
                        }
                    MFMA_SETTLE();
                }
                __builtin_amdgcn_sched_barrier(0);
                if (tile == 0) {
                    const int thr = rr_ - 4 * hh;
#pragma unroll
                    for (int kt = 0; kt < 4; ++kt) {
                        const int kd = 4 * hf + kt - w;
                        if (kd > 0) { asm volatile("" ::: "memory");
#pragma unroll
                            for (int i = 0; i < 16; ++i) x[kt][i] = -__builtin_inff(); }
                        else if (kd == 0) { asm volatile("" ::: "memory");
#pragma unroll
                            for (int i = 0; i < 16; ++i) if ((i & 3) + 8 * (i >> 2) > thr) x[kt][i] = -__builtin_inff(); }
                    }
                }
                float mx = mrun;
#pragma unroll
                for (int kt = 0; kt < 4; ++kt)
#pragma unroll
                    for (int i = 0; i < 16; ++i) mx = fmaxf(mx, x[kt][i]);
                mx = fmaxf(mx, __shfl_xor(mx, 32));
                const float mxs = mx * sc - 8.0f;
                const float resc = (hf > 0) ? fexp2((mrun - mx) * sc) : 0.f;
                lrun *= resc;
                if (hf > 0) {
#pragma unroll
                    for (int dt = 0; dt < 4; ++dt)
#pragma unroll
                        for (int i = 0; i < 16; ++i) o[dt][i] *= resc;
                }
                mrun = mx;
                float l = 0.f;
                const LAS unsigned char* vl = F.lds + 32768 + rr_ * 256;
#pragma unroll
                for (int kp = 0; kp < 2; ++kp) {
                    float pv[32];
#pragma unroll
                    for (int a2 = 0; a2 < 2; ++a2)
#pragma unroll
                        for (int i = 0; i < 16; ++i) { const float p = fexp2(__builtin_fmaf(x[2 * kp + a2][i], sc, -mxs)); l += p; pv[a2 * 16 + i] = p; }
                    i32x8 pf;
#pragma unroll
                    for (int q4 = 0; q4 < 8; ++q4) { int wv = 0; wv = __builtin_amdgcn_cvt_pk_fp8_f32(pv[4 * q4], pv[4 * q4 + 1], wv, false); wv = __builtin_amdgcn_cvt_pk_fp8_f32(pv[4 * q4 + 2], pv[4 * q4 + 3], wv, true); pf[q4] = wv; }
                    asm volatile("s_nop 3" ::: "memory");
                    const int c0 = 4 * (2 * hf + kp) + 2 * hh;
#pragma unroll
                    for (int dt = 0; dt < 4; ++dt) {
                        const i32x4 v0 = *(const LAS i32x4*)(vl + dt * 8192 + ((c0 ^ (rr_ & 15)) << 4)), v1 = *(const LAS i32x4*)(vl + dt * 8192 + (((c0 + 1) ^ (rr_ & 15)) << 4));
                        const i32x8 vf = __builtin_shufflevector(v0, v1, 0, 1, 2, 3, 4, 5, 6, 7);
                        if (hf == 0 && kp == 0) MFMA8Z(o[dt], vf, pf); else MFMA8(o[dt], vf, pf);
                    }
                    __builtin_amdgcn_sched_barrier(0);
                }
                MFMA_SETTLE();
                l += __shfl_xor(l, 32);
                lrun += l;
                __builtin_amdgcn_sched_barrier(0);
            }
            int tl2 = tid; asm volatile("" : "+v"(tl2)); const int hh2 = (tl2 >> 5) & 1;
            const bool valid2 = e_this >= 0; const int sl2 = e_this >> 2, rr2 = e_this & 3;
            if (valid2) {
                const float inv = frcp(lrun);
                const size_t pair = ((size_t)(b * SEQ + sl2) * NH + h) * 4 + rr2;
                unsigned char* po = PO + pair * HD;
                const float is8 = inv * (S8_PO / S8_V);
#pragma unroll
                for (int dt = 0; dt < 4; ++dt) {
                    unsigned wd[4];
#pragma unroll
                    for (int g4 = 0; g4 < 4; ++g4) wd[g4] = pk4_fp8(o[dt][4 * g4] * is8, o[dt][4 * g4 + 1] * is8, o[dt][4 * g4 + 2] * is8, o[dt][4 * g4 + 3] * is8);
                    const auto s0 = __builtin_amdgcn_permlane32_swap(wd[0], wd[2], false, false), s1 = __builtin_amdgcn_permlane32_swap(wd[1], wd[3], false, false);
                    *(u32x4*)(po + 32 * dt + 16 * hh2) = (u32x4){s0[0], s0[1], s1[0], s1[1]};
                }
                if (hh2 == 0) ML[pair] = (f32x2){mrun * sc, lrun * (1.0f / S8_P)};
            }
        }
        }
#undef MFMA8Z
#undef MFMA8
#undef MFMA_SETTLE
#undef ATT_ENTRY
#undef ATT_QLOAD
        __syncthreads();
    }
}

DI void moba_combine(const Frame& F) {
    PHASE_IDS;
    unsigned char* ws = F.ws;
    const unsigned char* PO = ws + O_PO; const f32x2* ML = (const f32x2*)(ws + O_ML);
    bf16_t* AO = (bf16_t*)(ws + O_Q);
    for (int it = blockIdx.x * 512 + tid_; it < T * 64; it += F.G * 512) {
        const int t = it >> 6, h = (it >> 3) & 7, dp = it & 7, sq = t & (SEQ - 1);
        const int nv = (sq >> 8) < 3 ? (sq >> 8) : 3;
        const size_t base = ((size_t)t * NH + h) * 4;
        f32x2 ml[4]; float ms = -3.0e38f;
#pragma unroll
        for (int r = 0; r < 4; ++r) { const bool ok = (r == 3) || (r < nv); ml[r] = ok ? ML[base + r] : (f32x2){-3.0e38f, 0.f}; ms = fmaxf(ms, ml[r][0]); }
        float wsum = 0.f; float wr[4];
#pragma unroll
        for (int r = 0; r < 4; ++r) { const bool ok = (r == 3) || (r < nv); wr[r] = ok ? ml[r][1] * fexp2(ml[r][0] - ms) : 0.f; wsum += wr[r]; }
        float acc[16];
#pragma unroll
        for (int i = 0; i < 16; ++i) acc[i] = 0.f;
#pragma unroll
        for (int r = 0; r < 4; ++r) {
            const bool ok = (r == 3) || (r < nv);
            if (ok) {
                const u32x4 a = *(const u32x4*)(PO + (base + r) * HD + dp * 16);
                const float wv = wr[r];
                const unsigned wd[4] = {a.x, a.y, a.z, a.w};
#pragma unroll
                for (int q = 0; q < 4; ++q) { const f32x2 lo2 = __builtin_amdgcn_cvt_pk_f32_fp8((int)wd[q], false), hi2 = __builtin_amdgcn_cvt_pk_f32_fp8((int)wd[q], true);
                    acc[4 * q] += wv * lo2.x; acc[4 * q + 1] += wv * lo2.y; acc[4 * q + 2] += wv * hi2.x; acc[4 * q + 3] += wv * hi2.y; }
            }
        }
        const float inv = frcp(wsum) * (1.0f / S8_PO);
        u32x4 o0, o1;
        o0.x = pk2(acc[0] * inv, acc[1] * inv); o0.y = pk2(acc[2] * inv, acc[3] * inv); o0.z = pk2(acc[4] * inv, acc[5] * inv); o0.w = pk2(acc[6] * inv, acc[7] * inv);
        o1.x = pk2(acc[8] * inv, acc[9] * inv); o1.y = pk2(acc[10] * inv, acc[11] * inv); o1.z = pk2(acc[12] * inv, acc[13] * inv); o1.w = pk2(acc[14] * inv, acc[15] * inv);
        bf16_t* op = AO + (size_t)t * D + h * HD + dp * 16;
        *(u32x4*)op = o0; *(u32x4*)(op + 8) = o1;
    }
}

#if SELFCHECK
DI void sc_sample(int i, int& b, int& sq, int& h) {
    const int special[12] = {0, 1, 255, 256, 257, 511, 512, 767, 768, 1023, 16383, 8191};
    b = i & 1; h = (i >> 1) & 7; const int k = i >> 4;
    sq = (k < 12) ? special[k] : (int)(((unsigned)(k * 7919 + i * 104729 + 12345)) % SEQ);
}
DI void attn_selfcheck_ref(const Frame& F) {
    PHASE_IDS;
    unsigned char* ws = F.ws;
    const bf16_t* Q = (const bf16_t*)(ws + O_Q); const unsigned char* Q8 = ws + O_Q8; const unsigned char* K8 = ws + O_K8; const unsigned char* VT8 = ws + O_VT8; const float* KM = (const float*)(ws + ZO_KM);
#define F8DEC(byte_) __builtin_amdgcn_cvt_f32_fp8((int)(unsigned)(byte_), 0)
    float* ref = (float*)(ws + WS_TOP);
    LAS float* ql = (LAS float*)F.lds; LAS float* gl = ql + 128; LAS float* pl = gl + 64; LAS float* red = pl + 1024; LAS int* sel = (LAS int*)(red + 16); LAS float* part = red + 32; LAS float* q8l = part + 512;
    for (int smp = blockIdx.x; smp < 512; smp += F.G) {
        int b, sq, h; sc_sample(smp, b, sq, h);
        const int j = sq >> 8;
        if (tid_ < 128) { const unsigned short v = Q[((size_t)(b * SEQ + sq)) * D + h * HD + tid_]; ql[tid_] = __uint_as_float((unsigned)v << 16); q8l[tid_] = F8DEC(Q8[((size_t)(b * SEQ + sq)) * D + h * HD + tid_]); }
        __syncthreads();
        if (tid_ < 64) { float g = -3.0e38f;
            if (tid_ < j) { float d0 = 0.f, d1 = 0.f, d2 = 0.f, d3 = 0.f; const float* kp = KM + (size_t)((b * NH + h) * NBLK + tid_) * HD;
                for (int d4 = 0; d4 < 32; ++d4) { d0 += ql[d4 * 4] * (kp[d4 * 4] * (1.0f / 256.0f)); d1 += ql[d4 * 4 + 1] * (kp[d4 * 4 + 1] * (1.0f / 256.0f)); d2 += ql[d4 * 4 + 2] * (kp[d4 * 4 + 2] * (1.0f / 256.0f)); d3 += ql[d4 * 4 + 3] * (kp[d4 * 4 + 3] * (1.0f / 256.0f)); }
                g = (d0 + d1) + (d2 + d3); }
            gl[tid_] = g; }
        __syncthreads();
        if (tid_ == 0) { float v0 = -3.0e38f, v1 = -3.0e38f, v2 = -3.0e38f; int i0 = 0, i1 = 0, i2 = 0;
            for (int n = 0; n < j; ++n) { const float g = gl[n];
                if (g > v0) { v2 = v1; i2 = i1; v1 = v0; i1 = i0; v0 = g; i0 = n; } else if (g > v1) { v2 = v1; i2 = i1; v1 = g; i1 = n; } else if (g > v2) { v2 = g; i2 = n; } }
            const int ns = j < 3 ? j : 3; sel[0] = ns > 0 ? i0 : -1; sel[1] = ns > 1 ? i1 : -1; sel[2] = ns > 2 ? i2 : -1; sel[3] = j; }
        __syncthreads();
        float mloc = -3.0e38f;
        for (int slot = tid_; slot < 1024; slot += 512) { const int bi = slot >> 8, key = slot & 255, blk = sel[bi]; float sc = -3.0e38f;
            if (blk >= 0 && (bi < 3 || blk * 256 + key <= sq)) { const unsigned char* kp = K8 + ((size_t)(b * SEQ + blk * 256 + key)) * D + h * HD; float a = 0.f;
                for (int d = 0; d < HD; ++d) a += q8l[d] * F8DEC(kp[d]);
                sc = a * (0.08838834764831845f / (S8_QK * S8_QK)); }
            pl[slot] = sc; mloc = fmaxf(mloc, sc); }
        mloc = fmaxf(mloc, __shfl_xor(mloc, 32)); mloc = fmaxf(mloc, __shfl_xor(mloc, 16)); mloc = fmaxf(mloc, __shfl_xor(mloc, 8)); mloc = fmaxf(mloc, __shfl_xor(mloc, 4)); mloc = fmaxf(mloc, __shfl_xor(mloc, 2)); mloc = fmaxf(mloc, __shfl_xor(mloc, 1));
        if (lane_ == 0) red[wave_] = mloc;
        __syncthreads();
        float mx = red[0]; for (int w = 1; w < 8; ++w) mx = fmaxf(mx, red[w]);
        __syncthreads();
        float sloc = 0.f;
        for (int slot = tid_; slot < 1024; slot += 512) { const float sc = pl[slot]; const float p = (sc > -1.0e38f) ? fexp2((sc - mx) * 1.4426950408889634f) : 0.f; pl[slot] = p; sloc += p; }
        sloc = wave_sum(sloc);
        if (lane_ == 0) red[wave_] = sloc;
        __syncthreads();
        float ssum = 0.f; for (int w = 0; w < 8; ++w) ssum += red[w];
        { const int d = tid_ & 127, bi = tid_ >> 7, blk = sel[bi]; float a = 0.f;
          if (blk >= 0) { const unsigned char* vp = VT8 + (size_t)(h * HD + d) * T + (size_t)b * SEQ + blk * 256;
              for (int key = 0; key < 256; ++key) a += pl[bi * 256 + key] * (F8DEC(vp[key]) * (1.0f / S8_V)); }
          part[tid_] = a; }
        __syncthreads();
        if (tid_ < 128) ref[(size_t)smp * 128 + tid_] = ((part[tid_] + part[128 + tid_]) + (part[256 + tid_] + part[384 + tid_])) / ssum;
        __syncthreads();
    }
#undef F8DEC
}
DI void attn_selfcheck_cmp(const Frame& F) {
    PHASE_IDS;
    unsigned char* ws = F.ws;
    const bf16_t* AO = (const bf16_t*)(ws + O_Q); const float* ref = (const float*)(ws + WS_TOP); unsigned* flag = (unsigned*)(ws + ZO_CNT) + 320;
    LAS float* red = (LAS float*)F.lds;
    for (int smp = blockIdx.x; smp < 512; smp += F.G) {
        int b, sq, h; sc_sample(smp, b, sq, h);
        float r = 0.f, a = 0.f;
        if (tid_ < 128) { r = ref[(size_t)smp * 128 + tid_]; a = __uint_as_float((unsigned)AO[((size_t)(b * SEQ + sq)) * D + h * HD + tid_] << 16); }
        float mr = fabsf(r); mr = fmaxf(mr, __shfl_xor(mr, 32)); mr = fmaxf(mr, __shfl_xor(mr, 16)); mr = fmaxf(mr, __shfl_xor(mr, 8)); mr = fmaxf(mr, __shfl_xor(mr, 4)); mr = fmaxf(mr, __shfl_xor(mr, 2)); mr = fmaxf(mr, __shfl_xor(mr, 1));
        if (lane_ == 0) red[wave_] = mr;
        __syncthreads();
        const float mx = fmaxf(red[0], red[1]);
        const bool bad = (tid_ < 128) && !(fabsf(a - r) <= SELFCHECK_TOL * mx + 0.001f);
        if (bad) __hip_atomic_store(flag, 1u, __ATOMIC_RELAXED, __HIP_MEMORY_SCOPE_AGENT);
        __syncthreads();
    }
}
#endif

DI void moe_router(const Frame& F) {
    PHASE_IDS;
    unsigned char* ws = F.ws;
    const bf16_t* H = (const bf16_t*)(ws + O_H4B); const float* rw = inp(I_ROUTER); const float* gn = inp(I_FFN_NORM) + D;
    LAS bf16_t* wh = (LAS bf16_t*)F.lds;
    LAS bf16_t* wl = wh + 32 * 16 * 40;
    LAS unsigned* lcnt = (LAS unsigned*)(F.lds + 98304);
    for (int i = tid_; i < 32 * 16 * 32; i += 512) {
        const int kk = i & 31, e = (i >> 5) & 15, ks = i >> 9, k = ks * 32 + kk;
        float w = 0.f; if (e < NE) w = rw[k * NE + e] * gn[k];
        const unsigned hi = pk2(w, 0.f) & 0xffffu; const float wr = w - __uint_as_float(hi << 16);
        wh[(ks * 16 + e) * 40 + kk] = (bf16_t)hi; wl[(ks * 16 + e) * 40 + kk] = (bf16_t)(pk2(wr, 0.f) & 0xffffu);
    }
    if (tid_ < 8) lcnt[tid_] = 0u;
    __syncthreads();
    unsigned* top = (unsigned*)(ws + WS_TOP);
    const int fr = lane_ & 15, fq = lane_ >> 4;
    for (int r0 = (blockIdx.x * 8 + wave_) * 16; r0 < T; r0 += F.G * 128) {
        const bf16_t* hp = H + (size_t)(r0 + fr) * D + 8 * fq;
        bf16x8 av[32];
#pragma unroll
        for (int ks = 0; ks < 32; ++ks) av[ks] = *(const bf16x8*)(hp + ks * 32);
        f32x4 acc = {0.f, 0.f, 0.f, 0.f}; float ss = 0.f;
#pragma unroll
        for (int ks = 0; ks < 32; ++ks) {
            const bf16x8 bh = *(const LAS bf16x8*)(wh + (ks * 16 + fr) * 40 + 8 * fq), bl = *(const LAS bf16x8*)(wl + (ks * 16 + fr) * 40 + 8 * fq);
            acc = __builtin_amdgcn_mfma_f32_16x16x32_bf16(bh, av[ks], acc, 0, 0, 0);
            acc = __builtin_amdgcn_mfma_f32_16x16x32_bf16(bl, av[ks], acc, 0, 0, 0);
#pragma unroll
            for (int j = 0; j < 8; ++j) { const float v = __uint_as_float((unsigned)(unsigned short)av[ks][j] << 16); ss += v * v; }
        }
        ss += __shfl_xor(ss, 16); ss += __shfl_xor(ss, 32);
        float lg[8];
#pragma unroll
        for (int j = 0; j < 4; ++j) { const float o = __shfl_xor(acc[j], 16); lg[j] = acc[j]; lg[4 + j] = o; }
        if (fq == 0) {
            const int row = r0 + fr;
            const float rstd = __builtin_amdgcn_rsqf(ss * (1.0f / D) + EPS);
            int e1 = 0; float b1 = lg[0];
#pragma unroll
            for (int e = 1; e < 8; ++e) if (lg[e] > b1) { b1 = lg[e]; e1 = e; }
            int e2 = -1; float b2 = -3.0e38f;
#pragma unroll
            for (int e = 0; e < 8; ++e) if (e != e1 && lg[e] > b2) { b2 = lg[e]; e2 = e; }
            const float w1 = frcp(1.0f + fexp2((b2 - b1) * rstd * 1.4426950408889634f)), w2 = 1.0f - w1;
            unsigned* tp = top + (size_t)row * 8;
            tp[0] = (unsigned)e1; tp[1] = (unsigned)e2; tp[2] = __float_as_uint(w1); tp[3] = __float_as_uint(w2); tp[4] = __float_as_uint(rstd);
            lds_add(lcnt + e1, 1u); lds_add(lcnt + e2, 1u);
        }
    }
    __syncthreads();
    if (tid_ < 8) atomicAdd((unsigned*)(ws + ZO_CNT) + tid_, lcnt[tid_]);
}

DI void moe_slots(const Frame& F) {
    PHASE_IDS;
    unsigned char* ws = F.ws;
    const unsigned* CNT = (const unsigned*)(ws + ZO_CNT); unsigned* CNT2 = (unsigned*)(ws + ZO_CNT) + 64;
    const unsigned* top = (const unsigned*)(ws + WS_TOP);
    int* slot_tok = (int*)(ws + WS_SLOT); float* slot_rstd = (float*)(ws + WS_SLOT + 512 * KiB); float* slot_gate = (float*)(ws + WS_SLOT + 1024 * KiB); int* slot_dst = (int*)(ws + WS_SLOT + 1536 * KiB);
    LAS unsigned* lc = (LAS unsigned*)F.lds; LAS unsigned* gb = lc + 8; LAS unsigned* sb = lc + 16; LAS unsigned* cn = lc + 32;
    if (tid_ == 0) { unsigned a = 0; for (int e = 0; e < 8; ++e) { const unsigned c = CNT[e]; cn[e] = c; sb[e] = a; a += ((c + 255u) >> 8) << 8; } sb[8] = a; }
    if (tid_ < 8) lc[tid_] = 0u;
    __syncthreads();
    for (int chunk = blockIdx.x; chunk < T / 128; chunk += F.G) {
        int e = 0, tok = 0, k = 0; unsigned lpos = 0;
        if (tid_ < 256) { tok = chunk * 128 + (tid_ >> 1); k = tid_ & 1; e = (int)top[(size_t)tok * 8 + k]; lpos = lds_add(lc + e, 1u); }
        __syncthreads();
        if (tid_ < 8) gb[tid_] = sb[tid_] + atomicAdd(CNT2 + tid_, lc[tid_]);
        __syncthreads();
        if (tid_ < 256) {
            const unsigned slot = gb[e] + lpos;
            slot_tok[slot] = tok; slot_rstd[slot] = __uint_as_float(top[(size_t)tok * 8 + 4]); slot_gate[slot] = __uint_as_float(top[(size_t)tok * 8 + 2 + k]); slot_dst[slot] = tok * 2 + k;
        }
        __syncthreads();
        if (tid_ < 8) lc[tid_] = 0u;
        __syncthreads();
    }
    if (blockIdx.x == 0) {
        for (int e = 0; e < 8; ++e)
            for (unsigned sl = sb[e] + cn[e] + tid_; sl < sb[e + 1]; sl += 512) { slot_tok[sl] = 0; slot_rstd[sl] = 0.f; slot_gate[sl] = 0.f; slot_dst[sl] = -1; }
    }
}

DI void moe_combine(const Frame& F) {
    PHASE_IDS;
    unsigned char* ws = F.ws;
    bf16_t* H = (bf16_t*)(ws + O_H5B); const bf16_t* Y1 = (const bf16_t*)(ws + O_Y1); const bf16_t* Y2 = (const bf16_t*)(ws + O_Y2); float* SQ = (float*)(ws + ZO_SQ5);
    for (int row0 = (blockIdx.x * 8 + wave_) * 4; row0 < T; row0 += F.G * 32) {
        u32x4 hw[4][2], aw[4][2], cw[4][2];
#pragma unroll
        for (int q = 0; q < 4; ++q)
#pragma unroll
            for (int j = 0; j < 2; ++j) { const size_t base = (size_t)(row0 + q) * D + j * 512 + lane_ * 8; hw[q][j] = *(const u32x4*)(H + base); aw[q][j] = *(const u32x4*)(Y1 + base); cw[q][j] = *(const u32x4*)(Y2 + base); }
#pragma unroll
        for (int q = 0; q < 4; ++q) {
            float ss = 0.f;
#pragma unroll
            for (int j = 0; j < 2; ++j) {
                const u32x4 h = hw[q][j], a = aw[q][j], c = cw[q][j]; float v[8];
                v[0] = bf_lo(h.x) + (bf_lo(a.x) + bf_lo(c.x)); v[1] = bf_hi(h.x) + (bf_hi(a.x) + bf_hi(c.x)); v[2] = bf_lo(h.y) + (bf_lo(a.y) + bf_lo(c.y)); v[3] = bf_hi(h.y) + (bf_hi(a.y) + bf_hi(c.y));
                v[4] = bf_lo(h.z) + (bf_lo(a.z) + bf_lo(c.z)); v[5] = bf_hi(h.z) + (bf_hi(a.z) + bf_hi(c.z)); v[6] = bf_lo(h.w) + (bf_lo(a.w) + bf_lo(c.w)); v[7] = bf_hi(h.w) + (bf_hi(a.w) + bf_hi(c.w));
                u32x4 w; w.x = pk2(v[0], v[1]); w.y = pk2(v[2], v[3]); w.z = pk2(v[4], v[5]); w.w = pk2(v[6], v[7]);
                *(u32x4*)(H + (size_t)(row0 + q) * D + j * 512 + lane_ * 8) = w;
#pragma unroll
                for (int e = 0; e < 8; ++e) ss += v[e] * v[e];
            }
            ss = wave_sum(ss);
            if (lane_ == 0) *(f32x4*)(SQ + (size_t)(row0 + q) * 4) = (f32x4){ss, 0.f, 0.f, 0.f};
        }
    }
}

DI void final_norm(const Frame& F) {
    PHASE_IDS;
    const bf16_t* H = (const bf16_t*)(F.ws + O_H6B); float* out = F.out; const float* SQ = (const float*)(F.ws + ZO_SQ6); const float* g = inp(I_FINAL_NORM);
    f32x4 gv[2][2];
#pragma unroll
    for (int j = 0; j < 2; ++j) { gv[j][0] = *(const f32x4*)(g + j * 512 + lane_ * 8); gv[j][1] = *(const f32x4*)(g + j * 512 + lane_ * 8 + 4); }
#if SELFCHECK
    const float poison = (__hip_atomic_load((unsigned*)(F.ws + ZO_CNT) + 320, __ATOMIC_RELAXED, __HIP_MEMORY_SCOPE_AGENT) != 0u) ? __builtin_nanf("") : 0.f;
#else
    const float poison = 0.f;
#endif
    for (int row0 = (blockIdx.x * 8 + wave_) * 4; row0 < T; row0 += F.G * 32) {
        u32x4 hw[4][2]; float rv[4];
#pragma unroll
        for (int q = 0; q < 4; ++q) { const size_t base = (size_t)(row0 + q) * D + lane_ * 8; hw[q][0] = *(const u32x4*)(H + base); hw[q][1] = *(const u32x4*)(H + base + 512); rv[q] = pg8::sq_rstd(SQ, row0 + q); }
#pragma unroll
        for (int q = 0; q < 4; ++q)
#pragma unroll
            for (int j = 0; j < 2; ++j) { const u32x4 w = hw[q][j]; float* op = out + (size_t)(row0 + q) * D + j * 512 + lane_ * 8;
                *(f32x4*)op = (f32x4){bf_lo(w.x), bf_hi(w.x), bf_lo(w.y), bf_hi(w.y)} * rv[q] * gv[j][0] + poison;
                *(f32x4*)(op + 4) = (f32x4){bf_lo(w.z), bf_hi(w.z), bf_lo(w.w), bf_hi(w.w)} * rv[q] * gv[j][1]; }
    }
}

constexpr int NPH = 21;
__global__ void __launch_bounds__(512, 2) fwd_kernel(Args args) {
    extern __shared__ __attribute__((aligned(16))) unsigned char lds_raw[];
    Frame F;
    F.lds = (LAS unsigned char*)lds_raw;
    F.G = gridDim.x; { int wv = __builtin_amdgcn_readfirstlane((int)threadIdx.x >> 6); asm volatile("" : "+s"(wv)); F.wv = wv; }
    F.out = args.out; F.ws = args.ws;
    unsigned char* ws = args.ws;
    for (int u = threadIdx.x; u < (LDS_BYTES - LDSCTL_OFF) / 4; u += 512) ((LAS unsigned*)(F.lds + LDSCTL_OFF))[u] = 0u;
    __syncthreads();
    volatile LAS unsigned* MISC = (volatile LAS unsigned*)(F.lds + MISC_OFF);
    XcdBarrier bar; bar.bar = (unsigned*)(ws + ZO_BAR); bar.x = 0; bar.st = nullptr;
    if (MK_N_LAUNCHES == 1) bar = xcd_barrier_post((unsigned*)(ws + ZO_BAR), MISC + 8, threadIdx.x == 0);
    const int lo = args.ph_lo, hi = args.ph_hi;
#ifdef ONLY_PH
#define IN(k) ((k) == ONLY_PH && lo <= (k) && (k) < hi)
#else
#define IN(k) (lo <= (k) && (k) < hi)
#endif
#define SEAM(k) do { if (IN(k) && IN((k) + 1)) { xcd_barrier(bar, F.wv == 0 && lane_id() == 0); } } while (0)
    LAS unsigned char* ring = F.lds;
    LAS float* part = (LAS float*)(F.lds + TAB_OFF);
    const int G = F.G, cid = (int)blockIdx.x;
    using namespace pg8;

    if (IN(0)) { for (int rep = 0; rep < DUPN(1); ++rep) p0_prologue(F); } SEAM(0);

    if (IN(1)) {
        if (I8_UP) { int rot = 0;
            conv_matrix_fp8(F, inp(I_W1), D, FF, ws + WO_F13, 0, 1, inp(I_FFN_NORM), 1.f, rot, (const float*)(ws + ZO_WMAX));
            conv_matrix_fp8(F, inp(I_W3), D, FF, ws + WO_F13, 0, 2, inp(I_FFN_NORM), 1.f, rot, (const float*)(ws + ZO_WMAX) + FF);
            if (I8_QKV) {
                conv_matrix_fp8(F, inp(I_WQ), D, D, ws + WO_QK, 0, 0, inp(I_ATTN_NORM), 1.f, rot, (const float*)(ws + ZO_WMQKV));
                conv_matrix_fp8(F, inp(I_WK), D, D, ws + WO_QK, D, 0, inp(I_KV_NORM), 1.f, rot, (const float*)(ws + ZO_WMQKV) + D);
                conv_matrix_fp8(F, inp(I_WV), D, D, ws + WO_V, 0, 0, inp(I_KV_NORM), 1.f, rot, (const float*)(ws + ZO_WMQKV) + 2 * D); } }
        { Gemm g{(const bf16_t*)(ws + O_POOLED), (const bf16_t*)(ws + WO_POOL), 256, nullptr, F.wv}; OrdPool S; S.init(T / 256, 4, G, cid);
          EpiResid<false> E{inp(I_X), (bf16_t*)(ws + O_H1B), (float*)(ws + ZO_SQ1), part, (FP8_FFN0 & 1) ? ws + O_H1F8 : nullptr, I8_UP ? ws + O_H1I8 : nullptr, 1.f};
          gemm_phase<EpiResid<false>, OrdPool, false>(ring, g, S, E); }
        { Gemm g{(const bf16_t*)(ws + WS_PB), (const bf16_t*)(ws + WO_P0), PD, nullptr, F.wv}; OrdStd S; S.init(T / 256, 4, G, cid);
          EpiPP E{(bf16_t*)(ws + O_PP0)};
          gemm_phase<EpiPP, OrdStd, false>(ring, g, S, E); }
    } SEAM(1);

    if (IN(2)) {
        OrdStd S; S.init(T / 256, 2 * FF / 256, G, cid);
        constexpr bool A8 = (FP8_FFN0 & 1) != 0, O8 = (FP8_FFN0 & 2) != 0;
        if constexpr (I8_UP) {
            Gemm g{(const bf16_t*)(ws + O_H1I8), (const bf16_t*)(ws + WO_F13), D / 2, nullptr, F.wv};
            EpiSwiGLU<true, O8, true> E{(bf16_t*)(ws + O_ACT0), FF, (const float*)(ws + ZO_SQ1), 1.0f / SI8_H, (const float*)(ws + ZO_WMAX)};
            gemm_phase<EpiSwiGLU<true, O8, true>, OrdStd, false, false, true>(ring, g, S, E);
        } else {
        Gemm g{(const bf16_t*)(ws + (A8 ? O_H1F8 : O_H1B)), (const bf16_t*)(ws + WO_F13), A8 ? D / 2 : D, nullptr, F.wv};
        EpiSwiGLU<true, O8> E{(bf16_t*)(ws + O_ACT0), FF, (const float*)(ws + ZO_SQ1), A8 ? 1.0f / (S8_H * S8_W13) : 1.f, nullptr};
        gemm_phase<EpiSwiGLU<true, O8>, OrdStd, false, A8>(ring, g, S, E);
        }
    } SEAM(2);

    if (IN(3)) {
        constexpr bool A8 = (FP8_FFN0 & 2) != 0;
        Gemm g{(const bf16_t*)(ws + O_ACT0), (const bf16_t*)(ws + WO_F2), A8 ? FF / 2 : FF, nullptr, F.wv}; OrdStd S; S.init(T / 256, 4, G, cid);
        EpiResid<true> E{ws + O_H1B, (bf16_t*)(ws + O_H2B), (float*)(ws + ZO_SQ2), part, nullptr, nullptr, A8 ? 1.0f / (S8_ACT * S8_WF2) : 1.f};
        gemm_phase<EpiResid<true>, OrdStd, false, A8>(ring, g, S, E);
    } SEAM(3);

    if (IN(4)) {
        Gemm g{(const bf16_t*)(ws + O_H2B), (const bf16_t*)(ws + WO_G0), D, nullptr, F.wv}; OrdStd S; S.init(T / 256, 4, G, cid);
        EpiPLE<I8_QKV != 0> E{(const bf16_t*)(ws + O_H2B), (const bf16_t*)(ws + O_PP0), (bf16_t*)(ws + O_H3B), (float*)(ws + ZO_SQ3), (const float*)(ws + ZO_SQ2), part, ws + O_H3F8};
        gemm_phase<EpiPLE<I8_QKV != 0>, OrdStd, false>(ring, g, S, E);
    } SEAM(4);

    if (IN(5)) {
        constexpr bool I8Q = I8_QKV != 0;
        const float* wmq = (const float*)(ws + ZO_WMQKV);
        const float qks = I8Q ? 1.0f / SI8_H3 : 1.f;
        { Gemm g{(const bf16_t*)(ws + (I8Q ? O_H3F8 : O_H3B)), (const bf16_t*)(ws + WO_QK), I8Q ? D / 2 : D, nullptr, F.wv}; OrdStd S; S.init(T / 256, 4, G, cid);
          EpiQK<false, I8Q> E{(bf16_t*)(ws + O_Q), ws + O_Q8, ws + O_K8, (const float*)(ws + ZO_SQ3), (const float*)(ws + WS_ROPE), (const float*)(ws + WS_ROPE) + SEQ * 16, (float*)(ws + ZO_KM), wmq, qks};
          gemm_phase<EpiQK<false, I8Q>, OrdStd, false, false, I8Q>(ring, g, S, E); }
        { Gemm g{(const bf16_t*)(ws + (I8Q ? O_H3F8 : O_H3B)), (const bf16_t*)(ws + WO_QK + (size_t)D * D * (I8Q ? 1 : 2)), I8Q ? D / 2 : D, nullptr, F.wv}; OrdStd S; S.init(T / 256, 4, G, cid);
          EpiQK<true, I8Q> E{(bf16_t*)(ws + O_Q), ws + O_Q8, ws + O_K8, (const float*)(ws + ZO_SQ3), (const float*)(ws + WS_ROPE), (const float*)(ws + WS_ROPE) + SEQ * 16, (float*)(ws + ZO_KM), wmq + D, qks};
          gemm_phase<EpiQK<true, I8Q>, OrdStd, false, false, I8Q>(ring, g, S, E); }
        { Gemm g{(const bf16_t*)(ws + WO_V), (const bf16_t*)(ws + O_H3F8), D / 2, nullptr, F.wv}; OrdStd S; S.init(4, T / 256, G, cid);
          EpiVT<I8Q> E{ws + O_VT8, (const float*)(ws + ZO_SQ3), wmq + 2 * D, I8Q ? 1.0f / SI8_H3 : 1.0f / (S8_H * S8_WKV)};
          gemm_phase<EpiVT<I8Q>, OrdStd, false, !I8Q, I8Q>(ring, g, S, E); }
    } SEAM(5);

    if (IN(6)) { moba_select(F);
#if SELFCHECK
        attn_selfcheck_ref(F);
#endif
    } SEAM(6);

    if (IN(7)) { moba_partial(F); } SEAM(7);
    if (IN(8)) { moba_combine(F); } SEAM(8);

    if (IN(9)) {
#if SELFCHECK
        attn_selfcheck_cmp(F); __syncthreads();
#endif
        { Gemm g{(const bf16_t*)(ws + O_Q), (const bf16_t*)(ws + WO_O), D, nullptr, F.wv}; OrdStd S; S.init(T / 256, 4, G, cid);
          EpiResid<true> E{ws + O_H3B, (bf16_t*)(ws + O_H4B), nullptr, part, ws + O_H4F8, nullptr, 1.f};
          gemm_phase<EpiResid<true>, OrdStd, false>(ring, g, S, E); }
        for (int rep = 0; rep < DUPN(3); ++rep) conv_moe_weights(F);
    } SEAM(9);

    if (IN(10)) { moe_router(F); } SEAM(10);
    if (IN(11)) { moe_slots(F); } SEAM(11);

    {
        LAS int* cumt = (LAS int*)(F.lds + TAB_OFF + 4096);
        int ntiles = 0;
        if (hi > 12 && lo <= 12 + NCHUNK) {
            const unsigned* CNT = (const unsigned*)(ws + ZO_CNT);
            if (F.wv == 0 && lane_id() == 0) { int a = 0; for (int e = 0; e < 8; ++e) { cumt[e] = a; a += (int)((CNT[e] + 255u) >> 8); } cumt[8] = a; }
            __syncthreads();
            ntiles = cumt[8];
        }
        const int left = (ntiles >= 256 && ntiles <= 256 + MAXCT) ? ntiles - 256 : 0;
        for (int k = 0; k <= NCHUNK; ++k) {
            if (IN(12 + k)) {
                if (k >= 1) {
                    const int c = k - 1, t0 = (c == 0) ? 0 : left + 64 * (c - 1), ntc = (c == 0) ? left : 64;
                    if (ntc > 0) {
                        Gemm g{(const bf16_t*)(ws + O_ACT1 + (size_t)(c & 1) * RG), (const bf16_t*)(ws + O_WE2), EFF / 2, nullptr, F.wv};
                        OrdMoE S; S.init(t0, ntc, 4, G, cid, D, 1, cumt);
                        EpiMoE2 E{(const int*)(ws + WS_SLOT + 1536 * KiB), (const float*)(ws + WS_SLOT + 1024 * KiB), (bf16_t*)(ws + O_Y1), (bf16_t*)(ws + O_Y2), 1.0f / (S8_ACT * S8_W2)};
                        gemm_phase<EpiMoE2, OrdMoE, false, true>(ring, g, S, E);
                    }
                }
                if (k < NCHUNK) {
                    const int c = k, t0 = (c == 0) ? 0 : left + 64 * (c - 1), ntc = (c == 0) ? left : 64;
                    if (ntc > 0) {
                        Gemm g{(const bf16_t*)(ws + O_H4F8), (const bf16_t*)(ws + O_WE13), D / 2, (const int*)(ws + WS_SLOT), F.wv};
                        OrdMoE S; S.init(t0, ntc, 2 * EFF / 256, G, cid, 2 * EFF, 0, cumt, (k == 1) ? left : 0);
                        EpiSwiGLU<false, true> E{(bf16_t*)(ws + O_ACT1 + (size_t)(c & 1) * RG), EFF, (const float*)(ws + WS_SLOT + 512 * KiB), 1.0f / (S8_H * S8_W13), nullptr};
                        gemm_phase<EpiSwiGLU<false, true>, OrdMoE, true, true>(ring, g, S, E);
                    }
                }
            } SEAM(12 + k);
        }
    }

    if (IN(18)) {
        moe_combine(F);
        { Gemm g{(const bf16_t*)(ws + WS_PB) + (size_t)T * PD, (const bf16_t*)(ws + WO_P1), PD, nullptr, F.wv}; OrdStd S; S.init(T / 256, 4, G, cid);
          EpiPP E{(bf16_t*)(ws + O_PP1)};
          gemm_phase<EpiPP, OrdStd, false>(ring, g, S, E); }
    } SEAM(18);

    if (IN(19)) {
        Gemm g{(const bf16_t*)(ws + O_H5B), (const bf16_t*)(ws + WO_G1), D, nullptr, F.wv}; OrdStd S; S.init(T / 256, 4, G, cid);
        EpiPLE<false> E{(const bf16_t*)(ws + O_H5B), (const bf16_t*)(ws + O_PP1), (bf16_t*)(ws + O_H6B), (float*)(ws + ZO_SQ6), (const float*)(ws + ZO_SQ5), part, nullptr};
        gemm_phase<EpiPLE<false>, OrdStd, false>(ring, g, S, E);
    } SEAM(19);

    if (IN(20)) { final_norm(F); }
#undef IN
#undef SEAM
}

extern "C" void kernel_launch(void* const* d_in, const int* in_sizes, int n_in, void* d_out, int out_size, void* d_ws, size_t ws_size, hipStream_t stream) {
    static int grid = 0;
    if (grid == 0) {
        if (n_in != 23 || in_sizes[0] != T * D || out_size != T * D || ws_size < WS_END) {
            fprintf(stderr, "kernel_launch: unexpected shapes or workspace (n_in %d, in0 %d, out %d, ws %zu, need %zu); nothing launched\n", n_in, n_in > 0 ? in_sizes[0] : -1, out_size, ws_size, (size_t)WS_END);
            grid = -1; return; }
        int dev = 0, cus = 0, per_cu = 0;
        if (hipGetDevice(&dev) != hipSuccess || hipDeviceGetAttribute(&cus, hipDeviceAttributeMultiprocessorCount, dev) != hipSuccess) { grid = -1; return; }
        if (hipFuncSetAttribute((const void*)fwd_kernel, hipFuncAttributeMaxDynamicSharedMemorySize, LDS_BYTES) != hipSuccess) { fprintf(stderr, "kernel_launch: hipFuncSetAttribute failed\n"); grid = -1; return; }
        if (hipOccupancyMaxActiveBlocksPerMultiprocessor(&per_cu, (const void*)fwd_kernel, 512, LDS_BYTES) != hipSuccess || per_cu < 1) { fprintf(stderr, "kernel_launch: occupancy query reports %d blocks per CU\n", per_cu); }
        (void)hipGetLastError();
        grid = cus;
    }
    if (grid < 0) return;
    if (hipMemsetAsync((char*)d_ws + WS_ZERO, 0, ZERO_BYTES, stream) != hipSuccess) { fprintf(stderr, "kernel_launch: memset failed\n"); return; }
    Args a{};
    for (int i = 0; i < 23; ++i) a.in[i] = (const float*)d_in[i];
    a.out = (float*)d_out; a.ws = (unsigned char*)d_ws;
    if (MK_N_LAUNCHES == 1) {
        a.ph_lo = 0; a.ph_hi = NPH;
        hipLaunchKernelGGL(fwd_kernel, dim3(grid), dim3(512), LDS_BYTES, stream, a);
    } else {
        for (int ph = 0; ph < NPH; ++ph) { a.ph_lo = ph; a.ph_hi = ph + 1; hipLaunchKernelGGL(fwd_kernel, dim3(grid), dim3(512), LDS_BYTES, stream, a); }
    }
    const hipError_t le = hipPeekAtLastError();
    if (le != hipSuccess) fprintf(stderr, "kernel_launch: launch failed: %s\n", hipGetErrorName(le));
}
```
